# Optimizing an MI355X kernel written in HIP

```python
import jax, jax.numpy as jnp
from jax import lax
import numpy as np

D_MODEL = 1024
BATCH = 16
SEQ = 2048
DEPTH = 4

CTX_LEN = 256
GRID_W = 64
EPS = 1e-6
ROPE_BASE = 10000.0
Q_BLOCK = 128

MLA_HEADS = 8
MLA_Q_RANK = 384
MLA_KV_RANK = 256
MLA_NOPE = 64
MLA_ROPE = 32
MLA_V = 64
MLA_SCALE = (MLA_NOPE + MLA_ROPE) ** -0.5

GLA_HEADS = 4
GLA_DK = 64
GLA_DV = 128
GLA_GATE_RANK = 16
GLA_GATE_TAU = 16.0
GLA_CHUNK = 64
GLA_QK_W = GLA_HEADS * GLA_DK
GLA_V_W = GLA_HEADS * GLA_DV

NA_HEADS = 8
NA_HEAD_DIM = 64
NA_KH = 8
NA_KW = 16
NA_W = NA_HEADS * NA_HEAD_DIM
NA_SCALE = NA_HEAD_DIM ** -0.5

FFN_HIDDEN = ((8 * D_MODEL + 3 * 256 - 1) // (3 * 256)) * 256

N_BRANCH = 3
MLA_OUT_W = MLA_HEADS * MLA_V
A_SPLITS = (MLA_Q_RANK, MLA_KV_RANK, MLA_ROPE)
B_SPLITS = (GLA_QK_W, GLA_QK_W, GLA_V_W, GLA_V_W, GLA_GATE_RANK, GLA_GATE_RANK)
C_SPLITS = (NA_W, NA_W, NA_W)
GROUP_SPLITS = (sum(A_SPLITS), sum(B_SPLITS), sum(C_SPLITS), N_BRANCH * D_MODEL)
IN_WIDTH = sum(GROUP_SPLITS)

kernel_name = "hybrid_mla_gla_natten_adaln_trunk"


def split_cols(z, sizes):
    idx = np.cumsum(sizes)[:-1].tolist()
    return jnp.split(z, idx, axis=-1)


def rms_norm(x, w):
    xf = x.astype(jnp.float32)
    y = xf * lax.rsqrt(jnp.mean(xf * xf, axis=-1, keepdims=True) + EPS)
    return (y * w.astype(jnp.float32)).astype(x.dtype)


def modulate(h, shift, scale):
    return h * (1 + scale) + shift


def to_heads(t, n_heads):
    b, l, w = t.shape
    return t.reshape(b, l, n_heads, w // n_heads).transpose(0, 2, 1, 3)


def from_heads(t):
    b, h, l, d = t.shape
    return t.transpose(0, 2, 1, 3).reshape(b, l, h * d)


def axial_rope_tables(length):
    t = jnp.arange(length)
    rows = (t // GRID_W).astype(jnp.float32)
    cols = (t % GRID_W).astype(jnp.float32)
    n_freq = MLA_ROPE // 4
    inv_freq = ROPE_BASE ** (-jnp.arange(n_freq, dtype=jnp.float32) / n_freq)
    ang = jnp.concatenate([rows[:, None] * inv_freq, cols[:, None] * inv_freq], axis=-1)
    return jnp.cos(ang), jnp.sin(ang)


def apply_rope(x, cos, sin):
    half = x.shape[-1] // 2
    x1, x2 = x[..., :half], x[..., half:]
    cos = cos.astype(x.dtype)
    sin = sin.astype(x.dtype)
    return jnp.concatenate([x1 * cos - x2 * sin, x1 * sin + x2 * cos], axis=-1)


def dense_attend(q, k, v):
    s = jnp.einsum('bhqd,bhkd->bhqk', q, k).astype(jnp.float32)
    p = jax.nn.softmax(s, axis=-1).astype(v.dtype)
    return jnp.einsum('bhqk,bhkd->bhqd', p, v)


def mla_queries(a, q_norm_w, w_q_up):
    q_down = a[..., :MLA_Q_RANK]
    q = to_heads(rms_norm(q_down, q_norm_w) @ w_q_up, MLA_HEADS)
    return q[..., :MLA_NOPE], q[..., MLA_NOPE:]


def mla_keys(a, kv_norm_w, w_kv_up):
    _, kv_down, k_rope = split_cols(a, A_SPLITS)
    kv = to_heads(rms_norm(kv_down, kv_norm_w) @ w_kv_up, MLA_HEADS)
    return kv[..., :MLA_NOPE], k_rope, kv[..., MLA_NOPE:]


def mla_attend(q_nope, q_rope, k_nope, k_rope, v):
    s = (jnp.einsum('bhqd,bhkd->bhqk', q_nope, k_nope)
         + jnp.einsum('bhqr,bkr->bhqk', q_rope, k_rope)).astype(jnp.float32) * MLA_SCALE
    p = jax.nn.softmax(s, axis=-1).astype(v.dtype)
    return jnp.einsum('bhqk,bhkd->bhqd', p, v)


def mla_mixer(a_lat, a_ctx, q_norm_w, kv_norm_w, w_q_up, w_kv_up, cos, sin, need_ctx_out):
    qn, qr = mla_queries(a_lat, q_norm_w, w_q_up)
    qr = apply_rope(qr, cos, sin)
    kn, kr, v = mla_keys(a_lat, kv_norm_w, w_kv_up)
    kr = apply_rope(kr, cos, sin)
    kn_c, kr_c, v_c = mla_keys(a_ctx, kv_norm_w, w_kv_up)
    kn_all = jnp.concatenate([kn, kn_c], axis=2)
    kr_all = jnp.concatenate([kr, kr_c], axis=1)
    v_all = jnp.concatenate([v, v_c], axis=2)
    b, h, l, _ = qn.shape
    nb = l // Q_BLOCK

    def blocks(t):
        return t.reshape(b, h, nb, Q_BLOCK, t.shape[-1]).transpose(2, 0, 1, 3, 4)

    o = lax.map(lambda qb: mla_attend(qb[0], qb[1], kn_all, kr_all, v_all), (blocks(qn), blocks(qr)))
    o = o.transpose(1, 2, 0, 3, 4).reshape(b, h, l, MLA_V)
    y_lat = from_heads(o)
    y_ctx = None
    if need_ctx_out:
        qn_c, qr_c = mla_queries(a_ctx, q_norm_w, w_q_up)
        y_ctx = from_heads(mla_attend(qn_c, qr_c, kn_c, kr_c, v_c))
    return y_lat, y_ctx


def gla_chunked(q, k, v, log_a, s0):
    b, h, l, _ = q.shape
    dv = v.shape[-1]
    n = l // GLA_CHUNK

    def ch(t):
        return t.reshape(b, h, n, GLA_CHUNK, t.shape[-1])

    q, k, v, log_a = ch(q), ch(k), ch(v), ch(log_a)
    cum = jnp.cumsum(log_a, axis=3)
    last = cum[:, :, :, -1:, :]
    q_dec = q * jnp.exp(cum)
    k_inv = k * jnp.exp(-cum)
    k_end = k * jnp.exp(last - cum)
    lower = jnp.tril(jnp.ones((GLA_CHUNK, GLA_CHUNK), dtype=bool))
    att = jnp.where(lower, jnp.einsum('bhncd,bhnsd->bhncs', q_dec, k_inv), 0.0)
    o_intra = jnp.einsum('bhncs,bhnse->bhnce', att, v)
    kv_chunk = jnp.einsum('bhncd,bhnce->bhnde', k_end, v)
    decay = jnp.exp(last[:, :, :, 0, :])

    def step(state, inp):
        dec, kv = inp
        return dec[..., None] * state + kv, state

    s_final, s_prev = lax.scan(step, s0, (jnp.moveaxis(decay, 2, 0), jnp.moveaxis(kv_chunk, 2, 0)))
    s_prev = jnp.moveaxis(s_prev, 0, 2)
    o_inter = jnp.einsum('bhncd,bhnde->bhnce', q_dec, s_prev)
    return (o_intra + o_inter).reshape(b, h, l, dv), s_final


def gla_bidir(q, k, v, la_f, la_b, s0_f, s0_b):
    o_f, s_f = gla_chunked(q, k, v, la_f, s0_f)
    flip = lambda t: jnp.flip(t, axis=2)
    o_b, s_b = gla_chunked(flip(q), flip(k), flip(v), flip(la_b), s0_b)
    return o_f + flip(o_b), s_f, s_b


def gla_log_decay(lr, w_up, b_up):
    z = (lr @ w_up + b_up).astype(jnp.float32)
    return to_heads(jax.nn.log_sigmoid(z) / GLA_GATE_TAU, GLA_HEADS)


def gla_mixer(b_lat, b_ctx, w_gate_f, b_gate_f, w_gate_b, b_gate_b, norm_w, need_ctx_out):
    def prep(t):
        q, k, v, g, lr_f, lr_b = split_cols(t, B_SPLITS)
        q = to_heads(q, GLA_HEADS).astype(jnp.float32) * (GLA_DK ** -0.5)
        k = to_heads(k, GLA_HEADS).astype(jnp.float32)
        v = to_heads(v, GLA_HEADS).astype(jnp.float32)
        return q, k, v, g, gla_log_decay(lr_f, w_gate_f, b_gate_f), gla_log_decay(lr_b, w_gate_b, b_gate_b)

    def finish(o, g):
        o = rms_norm(o.transpose(0, 2, 1, 3), norm_w)
        b, l = o.shape[0], o.shape[1]
        return o.reshape(b, l, GLA_V_W).astype(g.dtype) * jax.nn.silu(g)

    q_c, k_c, v_c, g_c, laf_c, lab_c = prep(b_ctx)
    s0 = jnp.zeros((q_c.shape[0], GLA_HEADS, GLA_DK, GLA_DV), jnp.float32)
    o_c, s_f, s_b = gla_bidir(q_c, k_c, v_c, laf_c, lab_c, s0, s0)
    q, k, v, g, laf, lab = prep(b_lat)
    o_l, _, _ = gla_bidir(q, k, v, laf, lab, s_f, s_b)
    y_ctx = finish(o_c, g_c) if need_ctx_out else None
    return finish(o_l, g), y_ctx


def na_mixer(c_lat, c_ctx, rpb, need_ctx_out):
    q, k, v = [to_heads(t, NA_HEADS) for t in split_cols(c_lat, C_SPLITS)]
    q_c, k_c, v_c = [to_heads(t, NA_HEADS) for t in split_cols(c_ctx, C_SPLITS)]
    b, h, l, d = q.shape
    rows = l // GRID_W
    kh = min(NA_KH, rows)
    grid = lambda t: t.reshape(b, h, rows, GRID_W, d)
    qg, kg, vg = grid(q * NA_SCALE), grid(k), grid(v)
    col = jnp.arange(GRID_W)
    col_start = jnp.clip(col - NA_KW // 2, 0, GRID_W - NA_KW)
    col_mask = (col[None, :] >= col_start[:, None]) & (col[None, :] < col_start[:, None] + NA_KW)
    col_off = jnp.clip(col[None, :] - col[:, None] + NA_KW - 1, 0, 2 * NA_KW - 2)
    band = kh * GRID_W

    def row_attend(r):
        r0 = jnp.clip(r - kh // 2, 0, rows - kh)
        kb = lax.dynamic_slice_in_dim(kg, r0, kh, axis=2)
        vb = lax.dynamic_slice_in_dim(vg, r0, kh, axis=2)
        qr = lax.dynamic_index_in_dim(qg, r, axis=2, keepdims=False)
        row_off = r0 + jnp.arange(kh) - r + NA_KH - 1
        bias = rpb[:, row_off[:, None, None], col_off[None, :, :]].transpose(0, 2, 1, 3)
        s_band = jnp.einsum('bhqd,bhrkd->bhqrk', qr, kb).astype(jnp.float32) + bias.astype(jnp.float32)
        s_band = jnp.where(col_mask[:, None, :], s_band, -jnp.inf)
        s_ctx = jnp.einsum('bhqd,bhkd->bhqk', qr, k_c).astype(jnp.float32)
        s = jnp.concatenate([s_band.reshape(b, h, GRID_W, band), s_ctx], axis=-1)
        p = jax.nn.softmax(s, axis=-1).astype(v.dtype)
        p_band = p[..., :band].reshape(b, h, GRID_W, kh, GRID_W)
        return (jnp.einsum('bhqrk,bhrkd->bhqd', p_band, vb)
                + jnp.einsum('bhqk,bhkd->bhqd', p[..., band:], v_c))

    o = lax.map(row_attend, jnp.arange(rows))
    y_lat = o.transpose(1, 0, 3, 2, 4).reshape(b, l, h * d)
    y_ctx = from_heads(dense_attend(q_c * NA_SCALE, k_c, v_c)) if need_ctx_out else None
    return y_lat, y_ctx


def merge_branches(ya, yb, yc, gates, w_a_o, w_b_o, w_c_o, w_out):
    ga, gb, gc = jnp.split(jax.nn.sigmoid(gates), N_BRANCH, axis=-1)
    return (ga * (ya @ w_a_o) + gb * (yb @ w_b_o) + gc * (yc @ w_c_o)) @ w_out


def swiglu(u, w_ffn_in, w_ffn_out):
    gate, up = jnp.split(u @ w_ffn_in, 2, axis=-1)
    return (jax.nn.silu(gate) * up) @ w_ffn_out


def hybrid_layer(h, hc, mod, modc, norm1_w, w_in, mla_q_norm_w, mla_kv_norm_w, mla_w_q_up, mla_w_kv_up,
                 gla_w_gate_f, gla_b_gate_f, gla_w_gate_b, gla_b_gate_b, gla_norm_w, na_rpb,
                 w_a_o, w_b_o, w_c_o, w_out, norm2_w, w_ffn_in, w_ffn_out, cos, sin, need_ctx_out):
    sh1, sc1, g1, sh2, sc2, g2 = mod
    csh1, csc1, cg1, csh2, csc2, cg2 = modc
    z = modulate(rms_norm(h, norm1_w), sh1, sc1) @ w_in
    zc = modulate(rms_norm(hc, norm1_w), csh1, csc1) @ w_in
    a, bb, cc, gates = split_cols(z, GROUP_SPLITS)
    a_c, bb_c, cc_c, gates_c = split_cols(zc, GROUP_SPLITS)
    ya, ya_c = mla_mixer(a, a_c, mla_q_norm_w, mla_kv_norm_w, mla_w_q_up, mla_w_kv_up, cos, sin, need_ctx_out)
    yb, yb_c = gla_mixer(bb, bb_c, gla_w_gate_f, gla_b_gate_f, gla_w_gate_b, gla_b_gate_b, gla_norm_w, need_ctx_out)
    yc, yc_c = na_mixer(cc, cc_c, na_rpb, need_ctx_out)
    h = h + g1 * merge_branches(ya, yb, yc, gates, w_a_o, w_b_o, w_c_o, w_out)
    h = h + g2 * swiglu(modulate(rms_norm(h, norm2_w), sh2, sc2), w_ffn_in, w_ffn_out)
    if need_ctx_out:
        hc = hc + cg1 * merge_branches(ya_c, yb_c, yc_c, gates_c, w_a_o, w_b_o, w_c_o, w_out)
        hc = hc + cg2 * swiglu(modulate(rms_norm(hc, norm2_w), csh2, csc2), w_ffn_in, w_ffn_out)
    return h, hc


def setup_inputs(seed: int = 0) -> dict:
    key = jax.random.key(seed)
    ks = iter(jax.random.split(key, 32))

    def nrm(shape, scale):
        return jax.random.normal(next(ks), shape, jnp.float32) * scale

    L, D = DEPTH, D_MODEL
    return {
        "x": nrm((BATCH, SEQ, D), 1.0),
        "c": nrm((BATCH, D), 1.0),
        "ctx": nrm((BATCH, CTX_LEN, D), 1.0),
        "c_ctx": nrm((D,), 1.0),
        "w_mod": nrm((L, D, 6 * D), 0.5 * D ** -0.5),
        "b_mod": nrm((L, 6 * D), 0.02),
        "norm1_w": 1.0 + nrm((L, D), 0.02),
        "w_in": nrm((L, D, IN_WIDTH), D ** -0.5),
        "mla_q_norm_w": 1.0 + nrm((L, MLA_Q_RANK), 0.02),
        "mla_kv_norm_w": 1.0 + nrm((L, MLA_KV_RANK), 0.02),
        "mla_w_q_up": nrm((L, MLA_Q_RANK, MLA_HEADS * (MLA_NOPE + MLA_ROPE)), MLA_Q_RANK ** -0.5),
        "mla_w_kv_up": nrm((L, MLA_KV_RANK, MLA_HEADS * (MLA_NOPE + MLA_V)), MLA_KV_RANK ** -0.5),
        "gla_w_gate_f": nrm((L, GLA_GATE_RANK, GLA_QK_W), GLA_GATE_RANK ** -0.5),
        "gla_b_gate_f": nrm((L, GLA_QK_W), 0.1),
        "gla_w_gate_b": nrm((L, GLA_GATE_RANK, GLA_QK_W), GLA_GATE_RANK ** -0.5),
        "gla_b_gate_b": nrm((L, GLA_QK_W), 0.1),
        "gla_norm_w": 1.0 + nrm((L, GLA_DV), 0.02),
        "na_rpb": nrm((L, NA_HEADS, 2 * NA_KH - 1, 2 * NA_KW - 1), 0.1),
        "w_a_o": nrm((L, MLA_OUT_W, D), MLA_OUT_W ** -0.5),
        "w_b_o": nrm((L, GLA_V_W, D), GLA_V_W ** -0.5),
        "w_c_o": nrm((L, NA_W, D), NA_W ** -0.5),
        "w_out": nrm((L, D, D), D ** -0.5),
        "norm2_w": 1.0 + nrm((L, D), 0.02),
        "w_ffn_in": nrm((L, D, 2 * FFN_HIDDEN), D ** -0.5),
        "w_ffn_out": nrm((L, FFN_HIDDEN, D), FFN_HIDDEN ** -0.5),
        "final_norm_w": 1.0 + nrm((D,), 0.02),
    }


def reference(x, c, ctx, c_ctx, w_mod, b_mod, norm1_w, w_in, mla_q_norm_w, mla_kv_norm_w, mla_w_q_up,
              mla_w_kv_up, gla_w_gate_f, gla_b_gate_f, gla_w_gate_b, gla_b_gate_b, gla_norm_w, na_rpb,
              w_a_o, w_b_o, w_c_o, w_out, norm2_w, w_ffn_in, w_ffn_out, final_norm_w):
    cos, sin = axial_rope_tables(x.shape[1])
    c_act = jax.nn.silu(c)[:, None, :]
    cc_act = jax.nn.silu(c_ctx)
    h, hc = x, ctx
    for i in range(DEPTH):
        mod = jnp.split(c_act @ w_mod[i] + b_mod[i], 6, axis=-1)
        modc = jnp.split(cc_act @ w_mod[i] + b_mod[i], 6, axis=-1)
        h, hc = hybrid_layer(h, hc, mod, modc, norm1_w[i], w_in[i], mla_q_norm_w[i], mla_kv_norm_w[i],
                             mla_w_q_up[i], mla_w_kv_up[i], gla_w_gate_f[i], gla_b_gate_f[i],
                             gla_w_gate_b[i], gla_b_gate_b[i], gla_norm_w[i], na_rpb[i],
                             w_a_o[i], w_b_o[i], w_c_o[i], w_out[i], norm2_w[i], w_ffn_in[i],
                             w_ffn_out[i], cos, sin, i < DEPTH - 1)
    return rms_norm(h, final_norm_w)
```

```cpp
#include <hip/hip_runtime.h>
#include <hip/hip_cooperative_groups.h>
#include <stdint.h>
#include <cstdio>
namespace cg = cooperative_groups;

typedef unsigned short bf16_t;
typedef short bf16x8 __attribute__((ext_vector_type(8)));
typedef float f32x4 __attribute__((ext_vector_type(4)));
typedef unsigned u32x4 __attribute__((ext_vector_type(4)));
typedef unsigned u32x2 __attribute__((ext_vector_type(2)));
#define DEVI __device__ __forceinline__

constexpr int D = 1024, SEQ = 2048, CTXL = 256, DEPTH = 4, NBATCH = 16;
constexpr int HB = 8;
constexpr int ML = HB * SEQ;
constexpr int MC = HB * CTXL;
constexpr int MH = ML + MC;
constexpr int INW = 6848, FFH = 2816;
constexpr int KVP = SEQ + CTXL;
constexpr int ZQD = 0, ZKVD = 384, ZKR = 640, ZGQ = 672, ZGK = 928, ZGG = 1184, ZLRF = 1696, ZLRB = 1712, ZNQ = 1728, ZNK = 2240, ZW = 2752;
constexpr int ZN = 3840;
constexpr float EPS = 1e-6f;
constexpr float LOG2E = 1.4426950408889634f;

struct P {
  const float *x, *c, *ctx, *c_ctx, *w_mod, *b_mod, *norm1_w, *w_in, *qn_w, *kvn_w, *wq_up, *wkv_up, *wgf, *bgf, *wgb, *bgb, *gla_nw, *rpb,
      *w_a_o, *w_b_o, *w_c_o, *w_out, *norm2_w, *w_ffn_in, *w_ffn_out, *final_w;
  float* out;
  bf16_t *WinA, *WinG, *Wq, *Wkv, *Wa, *Wb, *Wc, *Wout, *Wfi, *Wfo;
  float *mod, *ropec, *ropes, *hc;
  bf16_t *u, *z, *Qm, *Km, *Vtm, *Vtn, *Vtg;
  bf16_t* Sg;
  float* dec;
  bf16_t *ya, *yb, *yc, *mbuf, *act;
  unsigned* bar;
};

DEVI unsigned cvt_pk(float lo, float hi) { unsigned r; asm volatile("v_cvt_pk_bf16_f32 %0, %1, %2" : "=v"(r) : "v"(lo), "v"(hi)); return r; }
DEVI int otid8() { int t = threadIdx.x; asm volatile("" : "+v"(t)); return t; }
DEVI int otid() { return otid8() & 255; }
DEVI int osub() { return __builtin_amdgcn_readfirstlane(otid8() >> 8); }
DEVI int vbid() { return blockIdx.x * 2 + osub(); }
DEVI int vnb() { return gridDim.x * 2; }
DEVI float bf2f(bf16_t h) { return __uint_as_float(((unsigned)h) << 16); }
DEVI float bflo(unsigned w) { return __uint_as_float(w << 16); }
DEVI float bfhi(unsigned w) { return __uint_as_float(w & 0xffff0000u); }
DEVI bf16_t f2bf(float f) { return (bf16_t)(cvt_pk(f, 0.f) & 0xffffu); }
DEVI uint2 pack4(f32x4 v) { uint2 r; r.x = cvt_pk(v[0], v[1]); r.y = cvt_pk(v[2], v[3]); return r; }
DEVI float sigmoidf_(float x) { return __builtin_amdgcn_rcpf(1.f + __expf(-x)); }
DEVI f32x4 mfma16(bf16x8 a, bf16x8 b, f32x4 c) { return __builtin_amdgcn_mfma_f32_16x16x32_bf16(a, b, c, 0, 0, 0); }
DEVI float sumsq8(uint4 v) {
  float s = 0.f, t;
  t = bflo(v.x); s += t * t; t = bfhi(v.x); s += t * t; t = bflo(v.y); s += t * t; t = bfhi(v.y); s += t * t;
  t = bflo(v.z); s += t * t; t = bfhi(v.z); s += t * t; t = bflo(v.w); s += t * t; t = bfhi(v.w); s += t * t;
  return s;
}
DEVI float xrow16_max(float x) {
  auto s_ = __builtin_amdgcn_permlane16_swap(__float_as_uint(x), __float_as_uint(x), false, false);
  x = fmaxf(__uint_as_float(s_[0]), __uint_as_float(s_[1]));
  auto t_ = __builtin_amdgcn_permlane32_swap(__float_as_uint(x), __float_as_uint(x), false, false);
  return fmaxf(__uint_as_float(t_[0]), __uint_as_float(t_[1]));
}
DEVI void row_bp(int r, int& bl, int& pos) {
  if (r < ML) { bl = r >> 11; pos = r & 2047; } else { int rc = r - ML; bl = rc >> 8; pos = SEQ + (rc & 255); }
}


#define XB_TMO      128
#define XB_XCNT(j)  (256  + 64 * (j))
#define XB_XSUB(j)  (1280 + 64 * (j))
#define XB_XGEN(j)  (2304 + 64 * (j))
#define XB_TOP      3328
#define XB_TOPGEN   3392
#define XCD_BAR_WORDS 3456
#define XB_SPIN_CAP (1u << 22)
#define LAS __attribute__((address_space(3)))
DEVI unsigned xb_ld(unsigned* p) { return __hip_atomic_load(p, __ATOMIC_RELAXED, __HIP_MEMORY_SCOPE_AGENT); }
DEVI unsigned xb_add(unsigned* p, unsigned v) { return __hip_atomic_fetch_add(p, v, __ATOMIC_RELAXED, __HIP_MEMORY_SCOPE_AGENT); }
DEVI unsigned xb_xcc_id() { return (unsigned)__builtin_amdgcn_s_getreg((3 << 11) | 20) & 0xFu; }
#define XB_SPIN(cond, bar) do { unsigned _sp = 0; while (cond) { __builtin_amdgcn_s_sleep(1); \
    if ((++_sp & 255u) == 0u) { if (xb_ld(&(bar)[XB_TMO])) break; if (_sp > XB_SPIN_CAP) { atomicAdd(&(bar)[XB_TMO], 1u); break; } } } } while (0)
struct XcdBarrier { unsigned* bar; unsigned x; volatile LAS unsigned* st; };
DEVI XcdBarrier xcd_barrier_post(unsigned* bar, volatile LAS unsigned* st) {
  XcdBarrier b; b.bar = bar; b.x = xb_xcc_id(); b.st = st;
  if (threadIdx.x == 0) (void)xb_add(&bar[XB_XCNT(b.x)], 1u);
  return b;
}
DEVI void xcd_barrier_complete(unsigned* bar, unsigned x, unsigned& nloc, unsigned& nx) {
  const unsigned G = gridDim.x * gridDim.y * gridDim.z;
  unsigned sum, cnt, mine, sp = 0u;
  for (;;) {
    sum = 0u; cnt = 0u; mine = 0u;
#pragma unroll
    for (unsigned j = 0; j < 16; ++j) { const unsigned c = xb_ld(&bar[XB_XCNT(j)]); sum += c; cnt += (c > 0u) ? 1u : 0u; mine = (j == x) ? c : mine; }
    if (sum == G) break;
    __builtin_amdgcn_s_sleep(1);
    if ((++sp & 255u) == 0u) { if (xb_ld(&bar[XB_TMO])) break; if (sp > XB_SPIN_CAP) { atomicAdd(&bar[XB_TMO], 1u); break; } }
  }
  nloc = mine > 0u ? mine : 1u; nx = cnt > 0u ? cnt : 1u;
}
DEVI void xcd_barrier(const XcdBarrier& b) {
  asm volatile("s_waitcnt vmcnt(0)" ::: "memory");
  __syncthreads();
  if (threadIdx.x == 0) {
    unsigned* bar = b.bar;
    __builtin_amdgcn_s_waitcnt(0);
    unsigned nloc = b.st[0], nx = b.st[1];
    if (nloc == 0u) { xcd_barrier_complete(bar, b.x, nloc, nx); b.st[0] = nloc; b.st[1] = nx; }
    const unsigned old = xb_add(&bar[XB_XSUB(b.x)], 1u);
    const unsigned gen = old / nloc;
    if (old + 1u == (gen + 1u) * nloc) {
      __builtin_amdgcn_fence(__ATOMIC_RELEASE, "agent");
      asm volatile("s_waitcnt vmcnt(0)" ::: "memory");
      const unsigned og = xb_add(&bar[XB_TOP], 1u);
      const unsigned tg = og / nx;
      if (og + 1u == (tg + 1u) * nx) xb_add(&bar[XB_TOPGEN], 1u);
      else XB_SPIN(xb_ld(&bar[XB_TOPGEN]) == tg, bar);
      __builtin_amdgcn_fence(__ATOMIC_ACQUIRE, "agent");
      xb_add(&bar[XB_XGEN(b.x)], 1u);
      asm volatile("s_waitcnt vmcnt(0)" ::: "memory");
    } else {
      XB_SPIN(xb_ld(&bar[XB_XGEN(b.x)]) == gen, bar);
      __builtin_amdgcn_fence(__ATOMIC_ACQUIRE, "agent");
      asm volatile("s_waitcnt vmcnt(0)" ::: "memory");
    }
  }
  __syncthreads();
}

template <int N> DEVI void waitv() { asm volatile("s_waitcnt vmcnt(%0)" ::"n"(N) : "memory"); }
template <int MI>
DEVI void gemm_dma(const bf16_t* __restrict__ A, int lda, const bf16_t* __restrict__ Bt, int ldb, int K, f32x4 (&acc)[MI][4], unsigned char* smem) {
  constexpr int BM = MI * 32;
  constexpr int AF = MI / 2, AH = MI & 1;
  constexpr int STAGE = (BM + 128) * 64;
  const int tid = otid(), lane = tid & 63, wave = tid >> 6, wm = wave >> 1, wn = wave & 1;
  const int lr = tid >> 2, lc = (tid & 3) ^ ((-((lr >> 2) & 3)) & 3);
  const int fr = lane & 15, fq = lane >> 4;
  const int rofs = fr * 64 + ((fq ^ ((-((fr >> 2) & 3)) & 3)) * 16);
  const bf16_t* ag = A + (size_t)lr * lda + lc * 8;
  const bf16_t* bg = Bt + (size_t)lr * ldb + lc * 8;
  unsigned char* ldst = smem + tid * 16;
  const bool lowhalf = wave < 2;
#pragma unroll
  for (int mi = 0; mi < MI; ++mi)
#pragma unroll
    for (int ni = 0; ni < 4; ++ni) acc[mi][ni] = (f32x4){0.f, 0.f, 0.f, 0.f};
  asm volatile("s_waitcnt vmcnt(0)" ::: "memory");
  __syncthreads();
#define DMA_ISSUE(stage_, kt_)                                                                                                        \
  {                                                                                                                                   \
    unsigned char* sb_ = ldst + (stage_) * STAGE;                                                                                     \
    const int ko_ = (kt_) * 32;                                                                                                       \
    _Pragma("unroll") for (int i = 0; i < AF; ++i)                                                                                    \
        __builtin_amdgcn_global_load_lds((const unsigned*)(ag + (size_t)(64 * i) * lda + ko_), (LAS unsigned*)(sb_ + i * 4096), 16, 0, 0); \
    if (AH && lowhalf)                                                                                                                \
      __builtin_amdgcn_global_load_lds((const unsigned*)(ag + (size_t)(64 * AF) * lda + ko_), (LAS unsigned*)(sb_ + AF * 4096), 16, 0, 0); \
    _Pragma("unroll") for (int i = 0; i < 2; ++i)                                                                                     \
        __builtin_amdgcn_global_load_lds((const unsigned*)(bg + (size_t)(64 * i) * ldb + ko_), (LAS unsigned*)(sb_ + BM * 64 + i * 4096), 16, 0, 0); \
  }
  const int nk = K >> 5;
  DMA_ISSUE(0, 0)
  if (nk > 1) DMA_ISSUE(1, 1)
  int st = 0, st2 = 2;
  for (int kt = 0; kt < nk; ++kt) {
    if (kt + 1 < nk) { if (AH && lowhalf) waitv<AF + 3>(); else waitv<AF + 2>(); }
    else waitv<0>();
    __builtin_amdgcn_s_barrier();
    if (kt + 2 < nk) DMA_ISSUE(st2, kt + 2)
    const unsigned char* Ac = smem + st * STAGE + (wm * MI * 16) * 64 + rofs;
    const unsigned char* Bc = smem + st * STAGE + BM * 64 + (wn * 64) * 64 + rofs;
    bf16x8 bfr[4];
#pragma unroll
    for (int ni = 0; ni < 4; ++ni) bfr[ni] = *(const bf16x8*)(Bc + ni * 1024);
    bf16x8 af[MI];
#pragma unroll
    for (int mi = 0; mi < MI; ++mi) af[mi] = *(const bf16x8*)(Ac + mi * 1024);
#pragma unroll
    for (int mi = 0; mi < MI; ++mi) {
#pragma unroll
      for (int ni = 0; ni < 4; ++ni) acc[mi][ni] = mfma16(bfr[ni], af[mi], acc[mi][ni]);
    }
    __builtin_amdgcn_sched_group_barrier(0x100, 6, 0);
#pragma unroll
    for (int mi = 0; mi < MI; ++mi) {
      __builtin_amdgcn_sched_group_barrier(0x008, 4, 0);
      if (mi + 2 < MI) __builtin_amdgcn_sched_group_barrier(0x100, 1, 0);
    }
    st = (st == 2) ? 0 : st + 1;
    st2 = (st2 == 2) ? 0 : st2 + 1;
  }
  __syncthreads();
}


template <int MI>
DEVI void gemm_dma8(const bf16_t* __restrict__ A, int lda, const bf16_t* __restrict__ Bt, int ldb, int K, f32x4 (&acc)[MI][4], unsigned char* smem) {
  constexpr int BM = MI * 32;
  static_assert(MI == 8 || MI == 9, "gemm_dma8: MI is 8 or 9");
  constexpr bool ODD = (MI == 9);
  constexpr int STAGE = (BM + 256) * 64;
  const int tid = otid8(), lane = tid & 63, wave = __builtin_amdgcn_readfirstlane(tid >> 6), wm = wave >> 2, wn = wave & 3;
  const int lr = tid >> 2, lc = (tid & 3) ^ ((-((lr >> 2) & 3)) & 3);
  const int fr = lane & 15, fq = lane >> 4;
  const int rofs = fr * 64 + ((fq ^ ((-((fr >> 2) & 3)) & 3)) * 16);
  const unsigned voa = (unsigned)(lr * lda + lc * 8) * 2u, vob = (unsigned)(lr * ldb + lc * 8) * 2u;
  __amdgpu_buffer_rsrc_t ra, rb;
  {
    const unsigned long long pa = (unsigned long long)A, pb = (unsigned long long)Bt;
    const unsigned long long ua = ((unsigned long long)__builtin_amdgcn_readfirstlane((unsigned)(pa >> 32)) << 32) | (unsigned)__builtin_amdgcn_readfirstlane((unsigned)pa);
    const unsigned long long ub = ((unsigned long long)__builtin_amdgcn_readfirstlane((unsigned)(pb >> 32)) << 32) | (unsigned)__builtin_amdgcn_readfirstlane((unsigned)pb);
    ra = __builtin_amdgcn_make_buffer_rsrc((void*)ua, (short)0, 0x7ffffff0, 0x00020000);
    rb = __builtin_amdgcn_make_buffer_rsrc((void*)ub, (short)0, 0x7ffffff0, 0x00020000);
  }
  const int slda = __builtin_amdgcn_readfirstlane(lda) * 256, sldb = __builtin_amdgcn_readfirstlane(ldb) * 256;
  unsigned char* ldst = smem + wave * 1024;
  const bool extra = ODD && (wave < 2);
#pragma unroll
  for (int mi = 0; mi < MI; ++mi)
#pragma unroll
    for (int ni = 0; ni < 4; ++ni) acc[mi][ni] = (f32x4){0.f, 0.f, 0.f, 0.f};
  asm volatile("s_waitcnt vmcnt(0)" ::: "memory");
  __syncthreads();
#define DMA8_ISSUE(stage_, kt_)                                                                                                       \
  {                                                                                                                                   \
    unsigned char* sb_ = ldst + (stage_) * STAGE;                                                                                     \
    const int ko_ = (kt_) * 32;                                                                                                       \
    _Pragma("unroll") for (int i = 0; i < 2; ++i)                                                                                     \
        __builtin_amdgcn_raw_ptr_buffer_load_lds(ra, (LAS void*)(sb_ + i * 8192), 16, voa, i * slda + ko_ * 2, 0, 0);                 \
    if (extra)                                                                                                                        \
      __builtin_amdgcn_raw_ptr_buffer_load_lds(ra, (LAS void*)(sb_ + 16384), 16, voa, 2 * slda + ko_ * 2, 0, 0);                      \
    _Pragma("unroll") for (int i = 0; i < 2; ++i)                                                                                     \
        __builtin_amdgcn_raw_ptr_buffer_load_lds(rb, (LAS void*)(sb_ + BM * 64 + i * 8192), 16, vob, i * sldb + ko_ * 2, 0, 0);       \
  }
#define WAIT_NEXT(kt_)                                                                  \
  {                                                                                     \
    if ((kt_) + 3 < nk) { if (extra) waitv<10>(); else waitv<8>(); }                    \
    else if ((kt_) + 2 < nk) { if (extra) waitv<5>(); else waitv<4>(); }                \
    else waitv<0>();                                                                    \
  }
  const int nk = K >> 5;
  DMA8_ISSUE(0, 0)
  DMA8_ISSUE(1, 1)
  DMA8_ISSUE(2, 2)
  if (extra) waitv<10>(); else waitv<8>();
  __builtin_amdgcn_s_barrier();
  if (wm == 1) __builtin_amdgcn_s_barrier();
  __builtin_amdgcn_sched_barrier(0);
  for (int kt = 0; kt < nk; ++kt) {
    const int st = kt & 3;
    if (kt + 3 < nk) DMA8_ISSUE((kt + 3) & 3, kt + 3)
    const unsigned char* Ac = smem + st * STAGE + (wm * MI * 16) * 64 + rofs;
    const unsigned char* Bc = smem + st * STAGE + BM * 64 + (wn * 64) * 64 + rofs;
    bf16x8 bfr[4], af[MI];
#pragma unroll
    for (int ni = 0; ni < 4; ++ni) bfr[ni] = *(const bf16x8*)(Bc + ni * 1024);
#pragma unroll
    for (int mi = 0; mi < MI; ++mi) af[mi] = *(const bf16x8*)(Ac + mi * 1024);
    if (wm == 1) {
      WAIT_NEXT(kt)
      asm volatile("s_waitcnt lgkmcnt(0)" ::: "memory");
    }
    __builtin_amdgcn_sched_barrier(0);
    __builtin_amdgcn_s_barrier();
    __builtin_amdgcn_sched_barrier(0);
#pragma unroll
    for (int mi = 0; mi < MI; ++mi) {
#pragma unroll
      for (int ni = 0; ni < 4; ++ni) acc[mi][ni] = mfma16(bfr[ni], af[mi], acc[mi][ni]);
    }
    if (wm == 0) WAIT_NEXT(kt)
    __builtin_amdgcn_sched_barrier(0);
    __builtin_amdgcn_s_barrier();
    __builtin_amdgcn_sched_barrier(0);
  }
  if (wm == 0) __builtin_amdgcn_s_barrier();
  __syncthreads();
}
#define FOR_ACC8(MI_, ACC_, ...)                                                                 \
  {                                                                                              \
    const int t__ = otid8(), l__ = t__ & 63, w__ = t__ >> 6, wm__ = w__ >> 2, wn__ = w__ & 3;    \
    _Pragma("unroll") for (int mi = 0; mi < MI_; ++mi) {                                         \
      _Pragma("unroll") for (int ni = 0; ni < 4; ++ni) {                                         \
        const int m = wm__ * MI_ * 16 + mi * 16 + (l__ & 15), n = wn__ * 64 + ni * 16 + (l__ >> 4) * 4; \
        f32x4 v = ACC_[mi][ni];                                                                  \
        __VA_ARGS__                                                                              \
      }                                                                                          \
    }                                                                                            \
  }

DEVI void row_rstd128(const bf16_t* __restrict__ A, int lda, int K, float* rs_out) {
  const int tid = otid(), row = tid >> 1, half = tid & 1;
  const bf16_t* ap = A + (size_t)row * lda + half * (K >> 1);
  float s = 0.f;
#pragma unroll 4
  for (int k = 0; k < (K >> 1); k += 8) s += sumsq8(*(const uint4*)(ap + k));
  s += __shfl_xor(s, 1);
  if (half == 0) rs_out[row] = rsqrtf(s / (float)K + EPS);
}

#define FOR_ACC(MI_, ACC_, ...)                                                                  \
  {                                                                                              \
    const int t__ = otid(), l__ = t__ & 63, w__ = t__ >> 6, wm__ = w__ >> 1, wn__ = w__ & 1;     \
    _Pragma("unroll") for (int mi = 0; mi < MI_; ++mi) {                                         \
      _Pragma("unroll") for (int ni = 0; ni < 4; ++ni) {                                         \
        const int m = wm__ * MI_ * 16 + mi * 16 + (l__ & 15), n = wn__ * 64 + ni * 16 + (l__ >> 4) * 4; \
        f32x4 v = ACC_[mi][ni];                                                                  \
        __VA_ARGS__                                                                              \
      }                                                                                          \
    }                                                                                            \
  }

DEVI int map_col(int map, int n, int off) {
  if (map == 0) return n + off;
  if (map == 1) {
    if (n < 1184) return n;
    if (n < 1696) return n - 1184 + 1696;
    if (n < 1728) return n - 1696 + 2208;
    if (n < 2752) return n - 1728 + 2240;
    if (n < 2816) return -1;
    if (n < 3328) return n - 2816 + 1184;
    return n - 3328 + 3264;
  }
  const int tile = n >> 8, p = n & 255, wn = p >> 6, sub = (p >> 5) & 1, i = p & 31;
  return sub * FFH + tile * 128 + wn * 32 + i;
}
DEVI void convT(const float* __restrict__ src, int ld, int K, int N, bf16_t* __restrict__ dst, const float* __restrict__ kscale, int map, int off,
                unsigned char* smem) {
  float* tile = (float*)smem;
  const int tid = otid();
  const int tk = K >> 6, tn = N >> 6, nt = tk * tn;
  for (int it = vbid(); it < nt; it += vnb()) {
    const int k0 = (it % tk) * 64, n0 = (it / tk) * 64;
    __syncthreads();
    const int nn = tid & 63;
    const int sc = map_col(map, n0 + nn, off);
#pragma unroll
    for (int i = 0; i < 16; ++i) {
      const int kk = i * 4 + (tid >> 6);
      float v = 0.f;
      if (sc >= 0) { v = src[(size_t)(k0 + kk) * ld + sc]; if (kscale) v *= kscale[k0 + kk]; }
      tile[kk * 65 + nn] = v;
    }
    __syncthreads();
    const int n = tid >> 2, kc = tid & 3;
    unsigned w[8];
#pragma unroll
    for (int i = 0; i < 8; ++i) w[i] = cvt_pk(tile[(kc * 16 + 2 * i) * 65 + n], tile[(kc * 16 + 2 * i + 1) * 65 + n]);
    uint4* dp = (uint4*)(dst + (size_t)(n0 + n) * K + k0 + kc * 16);
    dp[0] = make_uint4(w[0], w[1], w[2], w[3]);
    dp[1] = make_uint4(w[4], w[5], w[6], w[7]);
  }
}
DEVI void phase_conv(const P& p, int l, unsigned char* smem) {
  convT(p.w_in + (size_t)l * D * INW, INW, D, ZN, p.WinA, nullptr, 1, 0, smem);
  convT(p.w_in + (size_t)l * D * INW, INW, D, 3072, p.WinG, nullptr, 0, 3776, smem);
  convT(p.wq_up + (size_t)l * 384 * 768, 768, 384, 768, p.Wq, p.qn_w + l * 384, 0, 0, smem);
  convT(p.wkv_up + (size_t)l * 256 * 1024, 1024, 256, 1024, p.Wkv, p.kvn_w + l * 256, 0, 0, smem);
  convT(p.w_a_o + (size_t)l * 512 * D, D, 512, D, p.Wa, nullptr, 0, 0, smem);
  convT(p.w_b_o + (size_t)l * 512 * D, D, 512, D, p.Wb, nullptr, 0, 0, smem);
  convT(p.w_c_o + (size_t)l * 512 * D, D, 512, D, p.Wc, nullptr, 0, 0, smem);
  convT(p.w_out + (size_t)l * D * D, D, D, D, p.Wout, nullptr, 0, 0, smem);
  convT(p.w_ffn_in + (size_t)l * D * 2 * FFH, 2 * FFH, D, 2 * FFH, p.Wfi, nullptr, 2, 0, smem);
  convT(p.w_ffn_out + (size_t)l * FFH * D, D, FFH, D, p.Wfo, nullptr, 0, 0, smem);
}

DEVI void phase_prep(const P& p, unsigned char* smem) {
  const int tid = otid();
  float* cact = (float*)smem;
  float* red = (float*)(smem + 40960);
  for (int it = vbid(); it < 4 * 96; it += vnb()) {
    const int l = it / 96, n0 = (it % 96) * 64;
    const int col = tid & 63, kg = tid >> 6;
    float acc[17];
#pragma unroll
    for (int b = 0; b < 17; ++b) acc[b] = 0.f;
    for (int pass = 0; pass < 2; ++pass) {
      __syncthreads();
      for (int e = tid; e < 512 * 17; e += 256) {
        const int kk = e & 511, b = e >> 9;
        const float v = (b < 16) ? p.c[b * D + pass * 512 + kk] : p.c_ctx[pass * 512 + kk];
        cact[kk * 20 + b] = v / (1.f + __expf(-v));
      }
      __syncthreads();
      const float* wp = p.w_mod + ((size_t)l * D + pass * 512 + kg * 128) * 6144 + n0 + col;
#pragma unroll 16
      for (int k = 0; k < 128; ++k) {
        const float w = wp[(size_t)k * 6144];
        const float* cp = cact + (kg * 128 + k) * 20;
#pragma unroll
        for (int b = 0; b < 17; ++b) acc[b] += cp[b] * w;
      }
    }
#pragma unroll
    for (int b = 0; b < 17; ++b) red[(kg * 17 + b) * 64 + col] = acc[b];
    __syncthreads();
    for (int e = tid; e < 17 * 64; e += 256) {
      const int b = e >> 6, cc = e & 63;
      const float v = red[(0 * 17 + b) * 64 + cc] + red[(1 * 17 + b) * 64 + cc] + red[(2 * 17 + b) * 64 + cc] + red[(3 * 17 + b) * 64 + cc];
      p.mod[((size_t)l * 17 + b) * 6144 + n0 + cc] = v + p.b_mod[l * 6144 + n0 + cc];
    }
  }
  for (int e = vbid() * 256 + tid; e < SEQ * 16; e += vnb() * 256) {
    const int t = e >> 4, j = e & 15, f = j & 7;
    const float pos = (j < 8) ? (float)(t >> 6) : (float)(t & 63);
    const float inv = powf(10000.0f, -(float)f / 8.0f);
    const float ang = pos * inv;
    p.ropec[e] = cosf(ang);
    p.ropes[e] = sinf(ang);
  }
}

DEVI void phase_norm(const P& p, int g, int layer, int which, const float* hl, const float* hcx, int Mrows) {
  const int tid = otid(), lane = tid & 63, wave = tid >> 6;
  const float* nw = (which ? p.norm2_w : p.norm1_w) + layer * D;
  const int stride = vnb() * 4;
  for (int r0 = vbid() * 4 + wave; r0 < Mrows; r0 += 2 * stride) {
    const int r1 = r0 + stride;
    const bool has1 = r1 < Mrows;
    const int rr1 = has1 ? r1 : r0;
    const float* h0 = (r0 < ML) ? hl + ((size_t)g * ML + r0) * D : hcx + ((size_t)g * MC + (r0 - ML)) * D;
    const float* h1 = (rr1 < ML) ? hl + ((size_t)g * ML + rr1) * D : hcx + ((size_t)g * MC + (rr1 - ML)) * D;
    f32x4 v0[4], v1[4];
#pragma unroll
    for (int i = 0; i < 4; ++i) { v0[i] = *(const f32x4*)(h0 + i * 256 + lane * 4); v1[i] = *(const f32x4*)(h1 + i * 256 + lane * 4); }
    float s0 = 0.f, s1 = 0.f;
#pragma unroll
    for (int i = 0; i < 4; ++i) {
      s0 += v0[i][0] * v0[i][0] + v0[i][1] * v0[i][1] + v0[i][2] * v0[i][2] + v0[i][3] * v0[i][3];
      s1 += v1[i][0] * v1[i][0] + v1[i][1] * v1[i][1] + v1[i][2] * v1[i][2] + v1[i][3] * v1[i][3];
    }
#pragma unroll
    for (int o = 1; o < 64; o <<= 1) { s0 += __shfl_xor(s0, o); s1 += __shfl_xor(s1, o); }
    const float rstd0 = rsqrtf(s0 * (1.f / D) + EPS), rstd1 = rsqrtf(s1 * (1.f / D) + EPS);
#pragma unroll
    for (int k = 0; k < 2; ++k) {
      if (k == 1 && !has1) break;
      const int r = k ? r1 : r0;
      const float rstd = k ? rstd1 : rstd0;
      const int b = (r < ML) ? g * HB + (r >> 11) : 16;
      const float* md = p.mod + ((size_t)layer * 17 + b) * 6144;
      const float* sh = md + (which ? 3072 : 0);
      const float* sc = md + (which ? 4096 : 1024);
      bf16_t* up = p.u + (size_t)r * D;
#pragma unroll
      for (int i = 0; i < 4; ++i) {
        const int c0 = i * 256 + lane * 4;
        const float4 w4 = *(const float4*)(nw + c0), s4 = *(const float4*)(sc + c0), h4 = *(const float4*)(sh + c0);
        const f32x4 v = k ? v1[i] : v0[i];
        f32x4 o;
        o[0] = v[0] * rstd * w4.x * (1.f + s4.x) + h4.x;
        o[1] = v[1] * rstd * w4.y * (1.f + s4.y) + h4.y;
        o[2] = v[2] * rstd * w4.z * (1.f + s4.z) + h4.z;
        o[3] = v[3] * rstd * w4.w * (1.f + s4.w) + h4.w;
        *(uint2*)(up + c0) = pack4(o);
      }
    }
  }
}

DEVI void phase_p1(const P& p, unsigned char* smem) {
  constexpr int MT = MH / 288, NT = ZN / 256;
  for (int it = blockIdx.x; it < MT * NT; it += gridDim.x) {
    const int mt = it % MT, nt = it / MT;
    const int m0 = mt * 288, n0 = nt * 256;
    f32x4 acc[9][4];
    gemm_dma8<9>(p.u + (size_t)m0 * D, D, p.WinA + (size_t)n0 * D, D, D, acc, smem);
    if (n0 < 2816) {
      FOR_ACC8(9, acc, {
        const int nn = n0 + n;
        if (nn >= ZNQ && nn < ZNQ + 512) v = v * (0.125f * LOG2E);
        if (nn < ZW) *(uint2*)(p.z + (size_t)(m0 + m) * ZW + nn) = pack4(v);
      })
    } else {
      FOR_ACC8(9, acc, {
        int bl, pos;
        row_bp(m0 + m, bl, pos);
        const int n1 = n0 + n - 2816;
        bf16_t* dst;
        if (n1 < 512) dst = p.Vtg + ((size_t)(bl * 4 + (n1 >> 7)) * 128 + (n1 & 127)) * KVP + pos;
        else { const int n2 = n1 - 512; dst = p.Vtn + ((size_t)(bl * 8 + (n2 >> 6)) * 64 + (n2 & 63)) * KVP + pos; }
        _Pragma("unroll") for (int j = 0; j < 4; ++j) dst[(size_t)j * KVP] = f2bf(v[j]);
      })
    }
  }
}

DEVI void gla_cum(const float* lrs, const float* __restrict__ wg, const float* __restrict__ bgp, int h, bool rev, float* tot, float (&cum)[16], float& last) {
  const int tid = otid(), d = tid & 63, tq = tid >> 6;
  float w[16];
#pragma unroll
  for (int k = 0; k < 16; ++k) w[k] = wg[k * 256 + h * 64 + d];
  const float b = bgp[h * 64 + d];
  float la[16];
#pragma unroll
  for (int i = 0; i < 16; ++i) {
    const float* lp = lrs + (tq * 16 + i) * 16;
    float zz = b;
#pragma unroll
    for (int k = 0; k < 16; ++k) zz += lp[k] * w[k];
    const float ls = fminf(zz, 0.f) - __logf(1.f + __expf(-fabsf(zz)));
    la[i] = ls * (1.f / 16.f);
  }
  float run = 0.f;
  if (!rev) {
#pragma unroll
    for (int i = 0; i < 16; ++i) { run += la[i]; cum[i] = run; }
  } else {
#pragma unroll
    for (int i = 15; i >= 0; --i) { run += la[i]; cum[i] = run; }
  }
  tot[tq * 64 + d] = run;
  __syncthreads();
  float off = 0.f, all = 0.f;
#pragma unroll
  for (int q2 = 0; q2 < 4; ++q2) {
    const float tv = tot[q2 * 64 + d];
    all += tv;
    const bool before = rev ? (q2 > tq) : (q2 < tq);
    if (before) off += tv;
  }
#pragma unroll
  for (int i = 0; i < 16; ++i) cum[i] += off;
  last = all;
  __syncthreads();
}

DEVI int gla_seq_index(int dir, int tc) { return dir == 0 ? tc : (tc < 4 ? 3 - tc : 39 - tc); }

DEVI void gla_g1_item(const P& p, int layer, int item, unsigned char* smem) {
  const int tc = item % 36, dir = (item / 36) & 1, h = (item / 72) & 3, bl = item / 288;
  const int tid = otid(), lane = tid & 63, wave = tid >> 6, d = tid & 63, tq = tid >> 6;
  const int fr = lane & 15, fq = lane >> 4;
  const int row0 = tc < 4 ? ML + bl * 256 + tc * 64 : bl * 2048 + (tc - 4) * 64;
  const int pos0 = tc < 4 ? SEQ + tc * 64 : (tc - 4) * 64;
  float* lrs = (float*)smem;
  float* tot = (float*)(smem + 8192);
  unsigned char* ke = smem + 10240;
  float lrv[4], kraw[16];
#pragma unroll
  for (int i = 0; i < 4; ++i) {
    const int e = tid + 256 * i, t = e >> 4, k = e & 15;
    lrv[i] = bf2f(p.z[(size_t)(row0 + t) * ZW + (dir ? ZLRB : ZLRF) + k]);
  }
#pragma unroll
  for (int i = 0; i < 16; ++i) kraw[i] = bf2f(p.z[(size_t)(row0 + tq * 16 + i) * ZW + ZGK + h * 64 + d]);
  bf16x8 vf[2][2];
#pragma unroll
  for (int ks = 0; ks < 2; ++ks)
#pragma unroll
    for (int a = 0; a < 2; ++a)
      vf[ks][a] = *(const bf16x8*)(p.Vtg + ((size_t)(bl * 4 + h) * 128 + (wave * 2 + a) * 16 + fr) * KVP + pos0 + ks * 32 + fq * 8);
  __syncthreads();
#pragma unroll
  for (int i = 0; i < 4; ++i) lrs[tid + 256 * i] = lrv[i];
  __syncthreads();
  float cum[16], last;
  gla_cum(lrs, (dir ? p.wgb : p.wgf) + layer * 16 * 256, (dir ? p.bgb : p.bgf) + layer * 256, h, dir != 0, tot, cum, last);
  unsigned w[8];
#pragma unroll
  for (int i = 0; i < 8; ++i) {
    const float k0 = kraw[2 * i] * __expf(last - cum[2 * i]);
    const float k1 = kraw[2 * i + 1] * __expf(last - cum[2 * i + 1]);
    w[i] = cvt_pk(k0, k1);
  }
  *(uint4*)(ke + d * 128 + (((tq * 2) ^ (d & 7)) * 16)) = make_uint4(w[0], w[1], w[2], w[3]);
  *(uint4*)(ke + d * 128 + (((tq * 2 + 1) ^ (d & 7)) * 16)) = make_uint4(w[4], w[5], w[6], w[7]);
  const int n = gla_seq_index(dir, tc);
  const size_t sidx = (size_t)((bl * 4 + h) * 2 + dir) * 36 + n;
  if (tq == 0) p.dec[sidx * 64 + d] = __expf(last);
  __syncthreads();
  f32x4 acc[2][4];
#pragma unroll
  for (int a = 0; a < 2; ++a)
#pragma unroll
    for (int b = 0; b < 4; ++b) acc[a][b] = (f32x4){0.f, 0.f, 0.f, 0.f};
#pragma unroll
  for (int ks = 0; ks < 2; ++ks) {
    bf16x8 kf[4];
#pragma unroll
    for (int b = 0; b < 4; ++b) kf[b] = *(const bf16x8*)(ke + (b * 16 + fr) * 128 + (((ks * 4 + fq) ^ (fr & 7)) * 16));
#pragma unroll
    for (int a = 0; a < 2; ++a)
#pragma unroll
      for (int b = 0; b < 4; ++b) acc[a][b] = mfma16(kf[b], vf[ks][a], acc[a][b]);
  }
  bf16_t* sp = p.Sg + sidx * 8192;
#pragma unroll
  for (int a = 0; a < 2; ++a)
#pragma unroll
    for (int b = 0; b < 4; ++b) *(uint2*)(sp + ((wave * 2 + a) * 16 + fr) * 64 + b * 16 + fq * 4) = pack4(acc[a][b]);
}

DEVI void gla_scan_item(const P& p, int item) {
  const int bhd = item >> 4, w = (item & 15) * 256 + otid();
  unsigned* base = (unsigned*)(p.Sg + (size_t)bhd * 36 * 8192) + w;
  const float* dp = p.dec + (size_t)bhd * 36 * 64 + (w & 31) * 2;
  unsigned kv[36];
  float dcx[36], dcy[36];
#pragma unroll
  for (int n = 0; n < 36; ++n) {
    kv[n] = base[(size_t)n * 4096];
    const float2 dc = *(const float2*)(dp + n * 64);
    dcx[n] = dc.x; dcy[n] = dc.y;
  }
  float s0 = 0.f, s1 = 0.f;
#pragma unroll
  for (int n = 0; n < 36; ++n) {
    base[(size_t)n * 4096] = cvt_pk(s0, s1);
    s0 = dcx[n] * s0 + bflo(kv[n]);
    s1 = dcy[n] * s1 + bfhi(kv[n]);
  }
}

DEVI void gla_g3_item(const P& p, int layer, int item, unsigned char* smem) {
  const int tc = item % 36, h = (item / 36) & 3, bl = item / 144;
  const int tid = otid(), lane = tid & 63, wave = tid >> 6, d = tid & 63, tq = tid >> 6;
  const int fr = lane & 15, fq = lane >> 4;
  const int row0 = tc < 4 ? ML + bl * 256 + tc * 64 : bl * 2048 + (tc - 4) * 64;
  const int pos0 = tc < 4 ? SEQ + tc * 64 : (tc - 4) * 64;
  float* lrs = (float*)smem;
  float* tot = (float*)(smem + 8192);
  unsigned char* qd = smem + 10240;
  unsigned char* ki = smem + 18432;
  unsigned char* st = smem + 26624;
  unsigned char* vt = smem + 43008;
  float lrv[8], qraw[16], kraw[16];
#pragma unroll
  for (int i = 0; i < 8; ++i) {
    const int e = tid + 256 * i, t = (e >> 5), k = e & 31;
    lrv[i] = bf2f(p.z[(size_t)(row0 + t) * ZW + ZLRF + k]);
  }
  u32x4 vtr[4];
#pragma unroll
  for (int i = 0; i < 4; ++i) {
    const int id = tid + 256 * i, row = id >> 3, ch = id & 7;
    vtr[i] = *(const u32x4*)(p.Vtg + ((size_t)(bl * 4 + h) * 128 + row) * KVP + pos0 + ch * 8);
  }
#pragma unroll
  for (int i = 0; i < 16; ++i) {
    const bf16_t* zr = p.z + (size_t)(row0 + tq * 16 + i) * ZW + h * 64 + d;
    qraw[i] = bf2f(zr[ZGQ]);
    kraw[i] = bf2f(zr[ZGK]);
  }
  u32x4 sg0[4], sg1[4];
  {
    const bf16_t* sp0 = p.Sg + ((size_t)((bl * 4 + h) * 2 + 0) * 36 + gla_seq_index(0, tc)) * 8192;
    const bf16_t* sp1 = p.Sg + ((size_t)((bl * 4 + h) * 2 + 1) * 36 + gla_seq_index(1, tc)) * 8192;
#pragma unroll
    for (int i = 0; i < 4; ++i) {
      const int id = tid + 256 * i, e = id >> 3, ch = id & 7;
      sg0[i] = *(const u32x4*)(sp0 + e * 64 + ch * 8);
      sg1[i] = *(const u32x4*)(sp1 + e * 64 + ch * 8);
    }
  }
  const int row = row0 + wave * 16 + fr;
  u32x2 gw[8];
#pragma unroll
  for (int eb = 0; eb < 8; ++eb) gw[eb] = *(const u32x2*)(p.z + (size_t)row * ZW + ZGG + h * 128 + eb * 16 + fq * 4);
  __syncthreads();
#pragma unroll
  for (int i = 0; i < 8; ++i) {
    const int e = tid + 256 * i, t = (e >> 5), k = e & 31;
    lrs[(k >> 4) * 1024 + t * 16 + (k & 15)] = lrv[i];
  }
#pragma unroll
  for (int i = 0; i < 4; ++i) {
    const int id = tid + 256 * i, rw = id >> 3, ch = id & 7;
    *(u32x4*)(vt + rw * 128 + ((ch ^ ((rw >> 1) & 7)) * 16)) = vtr[i];
  }
  f32x4 o[8];
#pragma unroll
  for (int eb = 0; eb < 8; ++eb) o[eb] = (f32x4){0.f, 0.f, 0.f, 0.f};
#pragma unroll
  for (int dir = 0; dir < 2; ++dir) {
    __syncthreads();
    float cum[16], last;
    gla_cum(lrs + dir * 1024, (dir ? p.wgb : p.wgf) + layer * 16 * 256, (dir ? p.bgb : p.bgf) + layer * 256, h, dir != 0, tot, cum, last);
#pragma unroll
    for (int i = 0; i < 16; ++i) {
      const int t = tq * 16 + i;
      const float qv = qraw[i] * 0.125f * __expf(cum[i]);
      const float kv = kraw[i] * __expf(-cum[i]);
      const int so = t * 128 + (((d >> 3) ^ (t & 7)) * 16) + (d & 7) * 2;
      *(bf16_t*)(qd + so) = f2bf(qv);
      *(bf16_t*)(ki + so) = f2bf(kv);
    }
#pragma unroll
    for (int i = 0; i < 4; ++i) {
      const int id = tid + 256 * i, e = id >> 3, ch = id & 7;
      *(u32x4*)(st + e * 128 + ((ch ^ (e & 7)) * 16)) = dir ? sg1[i] : sg0[i];
    }
    __syncthreads();
    bf16x8 qf[2];
#pragma unroll
    for (int ks = 0; ks < 2; ++ks) qf[ks] = *(const bf16x8*)(qd + (wave * 16 + fr) * 128 + (((ks * 4 + fq) ^ (fr & 7)) * 16));
    f32x4 at[4];
#pragma unroll
    for (int sb = 0; sb < 4; ++sb) {
      at[sb] = (f32x4){0.f, 0.f, 0.f, 0.f};
#pragma unroll
      for (int ks = 0; ks < 2; ++ks) {
        const bf16x8 kf = *(const bf16x8*)(ki + (sb * 16 + fr) * 128 + (((ks * 4 + fq) ^ (fr & 7)) * 16));
        at[sb] = mfma16(kf, qf[ks], at[sb]);
      }
      const int tt = wave * 16 + fr;
#pragma unroll
      for (int j = 0; j < 4; ++j) {
        const int s_ = sb * 16 + fq * 4 + j;
        const bool keep = dir ? (s_ >= tt) : (s_ <= tt);
        if (!keep) at[sb][j] = 0.f;
      }
    }
#pragma unroll
    for (int ks2 = 0; ks2 < 2; ++ks2) {
      const uint2 lo = pack4(at[2 * ks2]), hi = pack4(at[2 * ks2 + 1]);
      union { uint4 u; bf16x8 v; } pf; pf.u = make_uint4(lo.x, lo.y, hi.x, hi.y);
#pragma unroll
      for (int eb = 0; eb < 8; ++eb) {
        const int rw = eb * 16 + fr, sw = ((rw >> 1) & 7) << 1;
        union { uint2 u[2]; bf16x8 v; } vf;
        vf.u[0] = *(const uint2*)(vt + rw * 128 + (((ks2 * 8 + fq) ^ sw) * 8));
        vf.u[1] = *(const uint2*)(vt + rw * 128 + (((ks2 * 8 + 4 + fq) ^ sw) * 8));
        o[eb] = mfma16(vf.v, pf.v, o[eb]);
      }
    }
#pragma unroll
    for (int ks = 0; ks < 2; ++ks)
#pragma unroll
      for (int eb = 0; eb < 8; ++eb) {
        const bf16x8 sf = *(const bf16x8*)(st + (eb * 16 + fr) * 128 + (((ks * 4 + fq) ^ (fr & 7)) * 16));
        o[eb] = mfma16(sf, qf[ks], o[eb]);
      }
  }
  float ss = 0.f;
#pragma unroll
  for (int eb = 0; eb < 8; ++eb)
#pragma unroll
    for (int j = 0; j < 4; ++j) ss += o[eb][j] * o[eb][j];
  ss += __shfl_xor(ss, 16); ss += __shfl_xor(ss, 32);
  const float rstd = rsqrtf(ss * (1.f / 128.f) + EPS);
  const float* nw = p.gla_nw + layer * 128;
#pragma unroll
  for (int eb = 0; eb < 8; ++eb) {
    const int e0 = eb * 16 + fq * 4;
    const f32x4 gg = {bflo(gw[eb][0]), bfhi(gw[eb][0]), bflo(gw[eb][1]), bfhi(gw[eb][1])};
    f32x4 y;
#pragma unroll
    for (int j = 0; j < 4; ++j) y[j] = o[eb][j] * rstd * nw[e0 + j] * gg[j] * __builtin_amdgcn_rcpf(1.f + __expf(-gg[j]));
    *(uint2*)(p.yb + (size_t)row * 512 + h * 128 + e0) = pack4(y);
  }
}

DEVI void phase_p2(const P& p, int layer, unsigned char* smem) {
  constexpr int MT = MH / 128;
  float* rs = (float*)(smem + 3 * (128 + 128) * 64);
  const int nQ = MT * 6, nKV = MT * 8, nKR = 144, nG1 = HB * 4 * 2 * 36;
  for (int it = vbid(); it < nQ + nKV + nKR + nG1; it += vnb()) {
    if (it < nQ) {
      const int mt = it % MT, nt = it / MT, m0 = mt * 128, n0 = nt * 128;
      f32x4 acc[4][4];
      __syncthreads();
      row_rstd128(p.z + (size_t)m0 * ZW + ZQD, ZW, 384, rs);
      gemm_dma<4>(p.z + (size_t)m0 * ZW + ZQD, ZW, p.Wq + (size_t)n0 * 384, 384, 384, acc, smem);
      const int tid = otid(), lane = tid & 63, wave = tid >> 6, wm = wave >> 1, wn = wave & 1, fr = lane & 15, fq = lane >> 4;
#pragma unroll
      for (int mi = 0; mi < 4; ++mi) {
        const int m = wm * 64 + mi * 16 + fr, r = m0 + m;
        const float rstd = rs[m] * (0.10206207261596577f * LOG2E);
        const bool lat = r < ML;
        const int t = r & 2047;
#pragma unroll
        for (int np = 0; np < 2; ++np) {
          const int nb = n0 + wn * 64 + np * 32;
          f32x4 v0 = acc[mi][2 * np] * rstd, v1 = acc[mi][2 * np + 1] * rstd;
          if (lat && (nb % 96) == 64) {
            const float4 c4 = *(const float4*)(p.ropec + t * 16 + fq * 4), s4 = *(const float4*)(p.ropes + t * 16 + fq * 4);
            f32x4 cc = {c4.x, c4.y, c4.z, c4.w}, sn = {s4.x, s4.y, s4.z, s4.w};
            const f32x4 x1 = v0, x2 = v1;
            v0 = x1 * cc - x2 * sn;
            v1 = x1 * sn + x2 * cc;
          }
          *(uint2*)(p.Qm + (size_t)r * 768 + nb + fq * 4) = pack4(v0);
          *(uint2*)(p.Qm + (size_t)r * 768 + nb + 16 + fq * 4) = pack4(v1);
        }
      }
    } else if (it < nQ + nKV) {
      const int i2 = it - nQ, mt = i2 % MT, hd = i2 / MT, m0 = mt * 128, n0 = hd * 128;
      f32x4 acc[4][4];
      __syncthreads();
      row_rstd128(p.z + (size_t)m0 * ZW + ZKVD, ZW, 256, rs);
      gemm_dma<4>(p.z + (size_t)m0 * ZW + ZKVD, ZW, p.Wkv + (size_t)n0 * 256, 256, 256, acc, smem);
      FOR_ACC(4, acc, {
        int bl, pos;
        row_bp(m0 + m, bl, pos);
        v = v * rs[m];
        if (n < 64) {
          *(uint2*)(p.Km + ((size_t)(bl * 8 + hd) * KVP + pos) * 96 + n) = pack4(v);
        } else {
          bf16_t* dst = p.Vtm + ((size_t)(bl * 8 + hd) * 64 + (n - 64)) * KVP + pos;
          _Pragma("unroll") for (int j = 0; j < 4; ++j) dst[(size_t)j * KVP] = f2bf(v[j]);
        }
      })
    } else if (it < nQ + nKV + nKR) {
      const int i3 = it - nQ - nKV;
      const int tid = otid();
      const int r = i3 * 128 + (tid >> 1), half = tid & 1;
      int bl, pos;
      row_bp(r, bl, pos);
      const bf16_t* zr = p.z + (size_t)r * ZW + ZKR;
      const uint4 a = *(const uint4*)(zr + half * 8), b = *(const uint4*)(zr + 16 + half * 8);
      float x1[8] = {bflo(a.x), bfhi(a.x), bflo(a.y), bfhi(a.y), bflo(a.z), bfhi(a.z), bflo(a.w), bfhi(a.w)};
      float x2[8] = {bflo(b.x), bfhi(b.x), bflo(b.y), bfhi(b.y), bflo(b.z), bfhi(b.z), bflo(b.w), bfhi(b.w)};
      if (r < ML) {
#pragma unroll
        for (int j = 0; j < 8; ++j) {
          const float cs = p.ropec[pos * 16 + half * 8 + j], sn = p.ropes[pos * 16 + half * 8 + j];
          const float y1 = x1[j] * cs - x2[j] * sn, y2 = x1[j] * sn + x2[j] * cs;
          x1[j] = y1; x2[j] = y2;
        }
      }
      const uint4 o1 = make_uint4(cvt_pk(x1[0], x1[1]), cvt_pk(x1[2], x1[3]), cvt_pk(x1[4], x1[5]), cvt_pk(x1[6], x1[7]));
      const uint4 o2 = make_uint4(cvt_pk(x2[0], x2[1]), cvt_pk(x2[2], x2[3]), cvt_pk(x2[4], x2[5]), cvt_pk(x2[6], x2[7]));
#pragma unroll
      for (int hd = 0; hd < 8; ++hd) {
        bf16_t* kp = p.Km + ((size_t)(bl * 8 + hd) * KVP + pos) * 96 + 64;
        *(uint4*)(kp + half * 8) = o1;
        *(uint4*)(kp + 16 + half * 8) = o2;
      }
    } else {
      gla_g1_item(p, layer, it - nQ - nKV - nKR, smem);
    }
  }
}

struct Seg { const bf16_t* k; int ks; const bf16_t* vt; int vs; int nt; };

template <int DQK, int QB, bool NA>
DEVI void attn_item(const bf16_t* __restrict__ q, int qs, Seg s0, Seg s1, bf16_t* __restrict__ o, int os, float scale_l2,
                    const float* __restrict__ rpb_g, int na_roff, unsigned char* smem) {
  constexpr int CH = DQK / 8, RSK = (DQK == 96) ? 256 : 128, MASK = (DQK == 96) ? 15 : 7, NKS = DQK / 32;
  constexpr int KCH = 64 * CH / 256;
  const int tid = otid(), lane = tid & 63, wave = tid >> 6, fr = lane & 15, fq = lane >> 4;
  float* bias = (float*)(smem + 49152);
  __syncthreads();
  if (NA) {
    for (int e = tid; e < 15 * 31; e += 256) bias[e] = rpb_g[e] * LOG2E;
  }
  bf16x8 qf[QB][NKS];
#pragma unroll
  for (int qb = 0; qb < QB; ++qb)
#pragma unroll
    for (int ks = 0; ks < NKS; ++ks) qf[qb][ks] = *(const bf16x8*)(q + (size_t)(wave * QB * 16 + qb * 16 + fr) * qs + ks * 32 + fq * 8);
  f32x4 O[4][QB];
  float mrow[QB], lrow[QB];
#pragma unroll
  for (int qb = 0; qb < QB; ++qb) {
    mrow[qb] = -1e30f; lrow[qb] = 0.f;
#pragma unroll
    for (int db = 0; db < 4; ++db) O[db][qb] = (f32x4){0.f, 0.f, 0.f, 0.f};
  }
  const int T = s0.nt + s1.nt;
  uint4 rk0, rk1, rk2 = make_uint4(0, 0, 0, 0), rv0, rv1;
  for (int t = -1; t < T; ++t) {
    const int cur = t & 1;
    if (t + 1 < T) {
      const int t1 = t + 1;
      const bool first = t1 < s0.nt;
      const bf16_t* kp = first ? s0.k : s1.k;
      const bf16_t* vp = first ? s0.vt : s1.vt;
      const int ks_ = first ? s0.ks : s1.ks, vs_ = first ? s0.vs : s1.vs, tt = first ? t1 : t1 - s0.nt;
#define LDK_(i, dst) { const int id = tid + 256 * (i), row = id / CH, ch = id % CH; dst = *(const uint4*)(kp + (size_t)(tt * 64 + row) * ks_ + ch * 8); }
#define LDV_(i, dst) { const int id = tid + 256 * (i), row = id >> 3, ch = id & 7; dst = *(const uint4*)(vp + (size_t)row * vs_ + tt * 64 + ch * 8); }
      LDK_(0, rk0) LDK_(1, rk1) if (KCH > 2) LDK_(2, rk2)
      LDV_(0, rv0) LDV_(1, rv1)
    }
    if (t >= 0) {
    const unsigned char* kb = smem + cur * 24576;
    const unsigned char* vb = kb + 16384;
    f32x4 S[4][QB];
#pragma unroll
    for (int kbk = 0; kbk < 4; ++kbk) {
#pragma unroll
      for (int qb = 0; qb < QB; ++qb) S[kbk][qb] = (f32x4){0.f, 0.f, 0.f, 0.f};
#pragma unroll
      for (int ks = 0; ks < NKS; ++ks) {
        const bf16x8 kf = *(const bf16x8*)(kb + (kbk * 16 + fr) * RSK + (((ks * 4 + fq) ^ (fr & MASK)) * 16));
#pragma unroll
        for (int qb = 0; qb < QB; ++qb) S[kbk][qb] = mfma16(kf, qf[qb][ks], S[kbk][qb]);
      }
    }
    const bool band = NA && (t < s0.nt);
#pragma unroll
    for (int qb = 0; qb < QB; ++qb) {
      float mx = mrow[qb];
#pragma unroll
      for (int kbk = 0; kbk < 4; ++kbk)
#pragma unroll
        for (int j = 0; j < 4; ++j) {
          float s = S[kbk][qb][j];
          if (NA) {
            if (band) {
              const int qc = wave * 16 + fr, kc = kbk * 16 + fq * 4 + j;
              const int cs = min(max(qc - 8, 0), 48);
              const int co = min(max(kc - qc + 15, 0), 30);
              s += bias[(na_roff + t) * 31 + co];
              if (kc < cs || kc >= cs + 16) s = -1e30f;
            }
          }
          S[kbk][qb][j] = s;
          mx = fmaxf(mx, s);
        }
      mx = xrow16_max(mx);
      const float alpha = __builtin_amdgcn_exp2f(mrow[qb] - mx);
      mrow[qb] = mx;
      float ls = 0.f;
#pragma unroll
      for (int kbk = 0; kbk < 4; ++kbk)
#pragma unroll
        for (int j = 0; j < 4; ++j) {
          const float pv = __builtin_amdgcn_exp2f(S[kbk][qb][j] - mx);
          S[kbk][qb][j] = pv;
          ls += pv;
        }
      lrow[qb] = lrow[qb] * alpha + ls;
      if (__any(alpha != 1.f)) {
#pragma unroll
        for (int db = 0; db < 4; ++db) O[db][qb] = O[db][qb] * alpha;
      }
    }
#pragma unroll
    for (int ks2 = 0; ks2 < 2; ++ks2) {
      bf16x8 pf[QB];
#pragma unroll
      for (int qb = 0; qb < QB; ++qb) {
        const uint2 lo = pack4(S[2 * ks2][qb]), hi = pack4(S[2 * ks2 + 1][qb]);
        union { uint4 u; bf16x8 v; } cv; cv.u = make_uint4(lo.x, lo.y, hi.x, hi.y);
        pf[qb] = cv.v;
      }
#pragma unroll
      for (int db = 0; db < 4; ++db) {
        const int row = db * 16 + fr, sw = ((row >> 1) & 7) << 1;
        union { uint2 u[2]; bf16x8 v; } vf;
        vf.u[0] = *(const uint2*)(vb + row * 128 + (((ks2 * 8 + fq) ^ sw) * 8));
        vf.u[1] = *(const uint2*)(vb + row * 128 + (((ks2 * 8 + 4 + fq) ^ sw) * 8));
#pragma unroll
        for (int qb = 0; qb < QB; ++qb) O[db][qb] = mfma16(vf.v, pf[qb], O[db][qb]);
      }
    }
    }
    if (t + 1 < T) {
      unsigned char* kb2 = smem + (cur ^ 1) * 24576;
      unsigned char* vb2 = kb2 + 16384;
#define STK_(i, src) { const int id = tid + 256 * (i), row = id / CH, ch = id % CH; *(uint4*)(kb2 + row * RSK + ((ch ^ (row & MASK)) * 16)) = src; }
#define STV_(i, src) { const int id = tid + 256 * (i), row = id >> 3, ch = id & 7; *(uint4*)(vb2 + row * 128 + ((ch ^ ((row >> 1) & 7)) * 16)) = src; }
      STK_(0, rk0) STK_(1, rk1) if (KCH > 2) STK_(2, rk2)
      STV_(0, rv0) STV_(1, rv1)
    }
    __syncthreads();
  }
#pragma unroll
  for (int qb = 0; qb < QB; ++qb) {
    float l = lrow[qb];
    l += __shfl_xor(l, 16); l += __shfl_xor(l, 32);
    const float inv = 1.f / l;
    bf16_t* op = o + (size_t)(wave * QB * 16 + qb * 16 + fr) * os + fq * 4;
#pragma unroll
    for (int db = 0; db < 4; ++db) *(uint2*)(op + db * 16) = pack4(O[db][qb] * inv);
  }
}

constexpr int P3_NS = HB * 4 * 2 * 16, P3_NA = HB * 8 * 16, P3_NG = HB * 4 * 36, P3_NN = HB * 8 * 32, P3_NC = HB * 8 * 2;
constexpr int P3_SPLIT = P3_NS + P3_NA / 2;
DEVI void gla_g3_item(const P& p, int layer, int item, unsigned char* smem);
DEVI void phase_p3(const P& p, int layer, bool need_ctx, unsigned char* smem, int begin, int end) {
  const int nA = P3_NA, nN = P3_NN, nAc = need_ctx ? P3_NC : 0, nNc = nAc;
  const float mla_sc = 0.10206207261596577f * LOG2E;
  const float na_sc = 0.125f * LOG2E;
  const Seg none = {nullptr, 0, nullptr, 0, 0};
  const int tot = P3_NS + P3_NA + P3_NG + nN + nAc + nNc;
  if (end > tot) end = tot;
  for (int itg = begin + vbid(); itg < end; itg += vnb()) {
    if (itg < P3_NS) { gla_scan_item(p, itg); continue; }
    if (itg >= P3_NS + P3_NA && itg < P3_NS + P3_NA + P3_NG) {
      const int gi = itg - P3_NS - P3_NA;
      if (need_ctx || (gi % 36) >= 4) gla_g3_item(p, layer, gi, smem);
      continue;
    }
    const int it = itg < P3_NS + P3_NA ? itg - P3_NS : itg - P3_NS - P3_NG;
    if (it < nA) {
      const int qb = it & 15, hd = (it >> 4) & 7, bl = it >> 7;
      const int r0 = bl * 2048 + qb * 128;
      Seg s = {p.Km + (size_t)(bl * 8 + hd) * KVP * 96, 96, p.Vtm + (size_t)(bl * 8 + hd) * 64 * KVP, KVP, 36};
      attn_item<96, 2, false>(p.Qm + (size_t)r0 * 768 + hd * 96, 768, s, none, p.ya + (size_t)r0 * 512 + hd * 64, 512, mla_sc, nullptr, 0, smem);
    } else if (it < nA + nN) {
      const int i2 = it - nA, r = i2 & 31, hd = (i2 >> 5) & 7, bl = i2 >> 8;
      const int rr0 = min(max(r - 4, 0), 24);
      const int row0 = bl * 2048 + r * 64;
      Seg sb = {p.z + (size_t)(bl * 2048 + rr0 * 64) * ZW + ZNK + hd * 64, ZW, p.Vtn + (size_t)(bl * 8 + hd) * 64 * KVP + rr0 * 64, KVP, 8};
      Seg sc = {p.z + (size_t)(ML + bl * 256) * ZW + ZNK + hd * 64, ZW, p.Vtn + (size_t)(bl * 8 + hd) * 64 * KVP + SEQ, KVP, 4};
      attn_item<64, 1, true>(p.z + (size_t)row0 * ZW + ZNQ + hd * 64, ZW, sb, sc, p.yc + (size_t)row0 * 512 + hd * 64, 512, na_sc,
                             p.rpb + ((size_t)layer * 8 + hd) * 15 * 31, rr0 - r + 7, smem);
    } else if (it < nA + nN + nAc) {
      const int i3 = it - nA - nN, qb = i3 & 1, hd = (i3 >> 1) & 7, bl = i3 >> 4;
      const int r0 = ML + bl * 256 + qb * 128;
      Seg s = {p.Km + ((size_t)(bl * 8 + hd) * KVP + SEQ) * 96, 96, p.Vtm + (size_t)(bl * 8 + hd) * 64 * KVP + SEQ, KVP, 4};
      attn_item<96, 2, false>(p.Qm + (size_t)r0 * 768 + hd * 96, 768, s, none, p.ya + (size_t)r0 * 512 + hd * 64, 512, mla_sc, nullptr, 0, smem);
    } else {
      const int i4 = it - nA - nN - nAc, qb = i4 & 1, hd = (i4 >> 1) & 7, bl = i4 >> 4;
      const int r0 = ML + bl * 256 + qb * 128;
      Seg s = {p.z + (size_t)(ML + bl * 256) * ZW + ZNK + hd * 64, ZW, p.Vtn + (size_t)(bl * 8 + hd) * 64 * KVP + SEQ, KVP, 4};
      attn_item<64, 2, false>(p.z + (size_t)r0 * ZW + ZNQ + hd * 64, ZW, s, none, p.yc + (size_t)r0 * 512 + hd * 64, 512, na_sc, nullptr, 0, smem);
    }
  }
}

template <int MI>
DEVI void phase_p5(const P& p, int Mrows, unsigned char* smem) {
  constexpr int BM = MI * 32;
  const int MT = Mrows / BM;
  for (int it = vbid(); it < MT * 8; it += vnb()) {
    const int mt = it % MT, nt = it / MT, m0 = mt * BM, n0 = nt * 128;
    f32x4 macc[MI][4];
#pragma unroll
    for (int a = 0; a < MI; ++a)
#pragma unroll
      for (int b = 0; b < 4; ++b) macc[a][b] = (f32x4){0.f, 0.f, 0.f, 0.f};
    for (int br = 0; br < 3; ++br) {
      uint2 gs[MI][4];
      {
        f32x4 g[MI][4];
        gemm_dma<MI>(p.u + (size_t)m0 * D, D, p.WinG + (size_t)(br * 1024 + n0) * D, D, D, g, smem);
#pragma unroll
        for (int a = 0; a < MI; ++a)
#pragma unroll
          for (int b = 0; b < 4; ++b) {
            f32x4 sg;
#pragma unroll
            for (int j = 0; j < 4; ++j) sg[j] = sigmoidf_(g[a][b][j]);
            gs[a][b] = pack4(sg);
          }
      }
      f32x4 y[MI][4];
      const bf16_t* yb = br == 0 ? p.ya : (br == 1 ? p.yb : p.yc);
      const bf16_t* wb = br == 0 ? p.Wa : (br == 1 ? p.Wb : p.Wc);
      gemm_dma<MI>(yb + (size_t)m0 * 512, 512, wb + (size_t)n0 * 512, 512, 512, y, smem);
#pragma unroll
      for (int a = 0; a < MI; ++a)
#pragma unroll
        for (int b = 0; b < 4; ++b) {
          macc[a][b][0] += bflo(gs[a][b].x) * y[a][b][0];
          macc[a][b][1] += bfhi(gs[a][b].x) * y[a][b][1];
          macc[a][b][2] += bflo(gs[a][b].y) * y[a][b][2];
          macc[a][b][3] += bfhi(gs[a][b].y) * y[a][b][3];
        }
    }
    FOR_ACC(MI, macc, { *(uint2*)(p.mbuf + (size_t)(m0 + m) * D + n0 + n) = pack4(v); })
  }
}


DEVI uint2 ld_own(const void* ptr) {
  const unsigned long long w = __hip_atomic_load((const unsigned long long*)ptr, __ATOMIC_RELAXED, __HIP_MEMORY_SCOPE_AGENT);
  uint2 r; r.x = (unsigned)w; r.y = (unsigned)(w >> 32); return r;
}
template <int MI>
DEVI void phase_p5x(const P& p, int Mrows, unsigned char* smem) {
  constexpr int BM = MI * 32;
  const int MT = Mrows / BM;
  uint2* yscr = (uint2*)p.z + (size_t)blockIdx.x * (MI * 4 * 512);
  for (int pr = blockIdx.x; pr < MT * 4; pr += gridDim.x) {
    const int mt = pr % MT, nq = pr / MT, m0 = mt * BM, n0 = nq * 256;
    for (int br = 0; br < 3; ++br) {
      const bf16_t* ybr = br == 0 ? p.ya : (br == 1 ? p.yb : p.yc);
      const bf16_t* wbr = br == 0 ? p.Wa : (br == 1 ? p.Wb : p.Wc);
      {
        f32x4 y[MI][4];
        gemm_dma8<MI>(ybr + (size_t)m0 * 512, 512, wbr + (size_t)n0 * 512, 512, 512, y, smem);
        const int t8 = otid8();
#pragma unroll
        for (int mi = 0; mi < MI; ++mi)
#pragma unroll
          for (int ni = 0; ni < 4; ++ni) yscr[(mi * 4 + ni) * 512 + t8] = pack4(y[mi][ni]);
      }
      f32x4 g[MI][4];
      gemm_dma8<MI>(p.u + (size_t)m0 * D, D, p.WinG + (size_t)(br * 1024 + n0) * D, D, D, g, smem);
      {
        const int t8 = otid8(), l8 = t8 & 63, w8 = t8 >> 6, wm8 = w8 >> 2, wn8 = w8 & 3, fr8 = l8 & 15, fq8 = l8 >> 4;
        u32x2 yw[2][4], mw[2][4];
        bf16_t* mpp[2];
#define P5_LOAD(mi_, s_)                                                                                    \
        {                                                                                                   \
          mpp[s_] = p.mbuf + (size_t)(m0 + wm8 * MI * 16 + (mi_) * 16 + fr8) * D + n0 + wn8 * 64 + fq8 * 4; \
          _Pragma("unroll") for (int ni = 0; ni < 4; ++ni) {                                                \
            const uint2 a_ = ld_own(yscr + ((mi_) * 4 + ni) * 512 + t8);                                    \
            yw[s_][ni] = (u32x2){a_.x, a_.y};                                                               \
            if (br > 0) { const uint2 b_ = ld_own(mpp[s_] + ni * 16); mw[s_][ni] = (u32x2){b_.x, b_.y}; }   \
            else mw[s_][ni] = (u32x2){0u, 0u};                                                              \
          }                                                                                                 \
        }
        P5_LOAD(0, 0)
#pragma unroll
        for (int mi = 0; mi < MI; ++mi) {
          if (mi + 1 < MI) { if (mi & 1) P5_LOAD(mi + 1, 0) else P5_LOAD(mi + 1, 1) }
#pragma unroll
          for (int ni = 0; ni < 4; ++ni) {
            const f32x4 v = g[mi][ni];
            const u32x2 y2 = yw[mi & 1][ni], m2 = mw[mi & 1][ni];
            f32x4 outv;
            outv[0] = sigmoidf_(v[0]) * bflo(y2[0]) + bflo(m2[0]); outv[1] = sigmoidf_(v[1]) * bfhi(y2[0]) + bfhi(m2[0]);
            outv[2] = sigmoidf_(v[2]) * bflo(y2[1]) + bflo(m2[1]); outv[3] = sigmoidf_(v[3]) * bfhi(y2[1]) + bfhi(m2[1]);
            *(uint2*)(mpp[mi & 1] + ni * 16) = pack4(outv);
          }
        }
      }
    }
  }
}

template <int MI>
DEVI void phase_res(const P& p, int g, int layer, const bf16_t* A, int K, const bf16_t* W, int gate_off, const float* hl, const float* hcx, int Mrows,
                    unsigned char* smem) {
  constexpr int BM = MI * 32;
  const int MT = Mrows / BM;
  for (int it = blockIdx.x; it < MT * 4; it += gridDim.x) {
    const int mt = it % MT, nt = it / MT, m0 = mt * BM, n0 = nt * 256;
    f32x4 acc[MI][4];
    gemm_dma8<MI>(A + (size_t)m0 * K, K, W + (size_t)n0 * K, K, K, acc, smem);
    {
      const int t8 = otid8(), l8 = t8 & 63, w8 = t8 >> 6, wm8 = w8 >> 2, wn8 = w8 & 3, fr8 = l8 & 15, fq8 = l8 >> 4;
      const int cb = n0 + wn8 * 64 + fq8 * 4;
      f32x4 hv[2][4], gv[2][4];
      float* dstp[2];
#define RES_LOAD(mi_, s_)                                                                                   \
      {                                                                                                     \
        const int r_ = m0 + wm8 * MI * 16 + (mi_) * 16 + fr8;                                               \
        const bool lat_ = r_ < ML;                                                                          \
        const size_t ro_ = lat_ ? ((size_t)g * ML + r_) * D : ((size_t)g * MC + (r_ - ML)) * D;            \
        const float* src_ = (lat_ ? hl : hcx) + ro_ + cb;                                                   \
        dstp[s_] = (lat_ ? p.out : p.hc) + ro_ + cb;                                                        \
        const int b_ = lat_ ? g * HB + (r_ >> 11) : 16;                                                     \
        const float* gp_ = p.mod + ((size_t)layer * 17 + b_) * 6144 + gate_off + cb;                        \
        _Pragma("unroll") for (int ni = 0; ni < 4; ++ni) { hv[s_][ni] = *(const f32x4*)(src_ + ni * 16); gv[s_][ni] = *(const f32x4*)(gp_ + ni * 16); } \
      }
      RES_LOAD(0, 0)
#pragma unroll
      for (int mi = 0; mi < MI; ++mi) {
        if (mi + 1 < MI) { if (mi & 1) RES_LOAD(mi + 1, 0) else RES_LOAD(mi + 1, 1) }
#pragma unroll
        for (int ni = 0; ni < 4; ++ni) *(f32x4*)(dstp[mi & 1] + ni * 16) = hv[mi & 1][ni] + gv[mi & 1][ni] * acc[mi][ni];
      }
    }
  }
}

template <int MI>
DEVI void phase_p7(const P& p, int Mrows, unsigned char* smem) {
  constexpr int BM = MI * 32;
  const int MT = Mrows / BM;
  for (int it = blockIdx.x; it < MT * 22; it += gridDim.x) {
    const int mt = it % MT, nt = it / MT, m0 = mt * BM, n0 = nt * 256;
    f32x4 acc[MI][4];
    gemm_dma8<MI>(p.u + (size_t)m0 * D, D, p.Wfi + (size_t)n0 * D, D, D, acc, smem);
    const int tid = otid8(), lane = tid & 63, wave = tid >> 6, wm = wave >> 2, wn = wave & 3, fr = lane & 15, fq = lane >> 4;
#pragma unroll
    for (int mi = 0; mi < MI; ++mi) {
      const int r = m0 + wm * MI * 16 + mi * 16 + fr;
#pragma unroll
      for (int ni = 0; ni < 2; ++ni) {
        f32x4 a;
#pragma unroll
        for (int j = 0; j < 4; ++j) { const float gv = acc[mi][ni][j]; a[j] = gv * __builtin_amdgcn_rcpf(1.f + __expf(-gv)) * acc[mi][ni + 2][j]; }
        *(uint2*)(p.act + (size_t)r * FFH + nt * 128 + wn * 32 + ni * 16 + fq * 4) = pack4(a);
      }
    }
  }
}

DEVI void phase_final(const P& p) {
  const int tid = otid(), lane = tid & 63, wave = tid >> 6;
  const int stride = vnb() * 4, NR = NBATCH * SEQ;
  for (int r0 = vbid() * 4 + wave; r0 < NR; r0 += 2 * stride) {
    const int r1 = r0 + stride;
    const bool has1 = r1 < NR;
    float* h0 = p.out + (size_t)r0 * D;
    float* h1 = p.out + (size_t)(has1 ? r1 : r0) * D;
    f32x4 v0[4], v1[4];
#pragma unroll
    for (int i = 0; i < 4; ++i) { v0[i] = *(const f32x4*)(h0 + i * 256 + lane * 4); v1[i] = *(const f32x4*)(h1 + i * 256 + lane * 4); }
    float s0 = 0.f, s1 = 0.f;
#pragma unroll
    for (int i = 0; i < 4; ++i) {
      s0 += v0[i][0] * v0[i][0] + v0[i][1] * v0[i][1] + v0[i][2] * v0[i][2] + v0[i][3] * v0[i][3];
      s1 += v1[i][0] * v1[i][0] + v1[i][1] * v1[i][1] + v1[i][2] * v1[i][2] + v1[i][3] * v1[i][3];
    }
#pragma unroll
    for (int o = 1; o < 64; o <<= 1) { s0 += __shfl_xor(s0, o); s1 += __shfl_xor(s1, o); }
    const float rstd0 = rsqrtf(s0 * (1.f / D) + EPS), rstd1 = rsqrtf(s1 * (1.f / D) + EPS);
#pragma unroll
    for (int i = 0; i < 4; ++i) {
      const float4 w4 = *(const float4*)(p.final_w + i * 256 + lane * 4);
      const f32x4 wv = {w4.x, w4.y, w4.z, w4.w};
      *(f32x4*)(h0 + i * 256 + lane * 4) = v0[i] * rstd0 * wv;
      if (has1) *(f32x4*)(h1 + i * 256 + lane * 4) = v1[i] * rstd1 * wv;
    }
  }
}

constexpr int SUBLDS = 60416;
constexpr int DYN_LDS = 4 * (288 + 256) * 64;
static_assert(2 * SUBLDS <= DYN_LDS, "LDS regions");
__global__ void __launch_bounds__(512, 2) fwd_megakernel(P p) {
  extern __shared__ __attribute__((aligned(16))) unsigned char smem[];
  __shared__ uint4 xb_words;
  cg::grid_group grid = cg::this_grid();
  if (threadIdx.x == 0) xb_words = make_uint4(0u, 0u, 0u, 0u);
  __syncthreads();
  XcdBarrier xb = xcd_barrier_post(p.bar, (volatile LAS unsigned*)&xb_words);
  unsigned char* smh = smem + osub() * SUBLDS;
  phase_prep(p, smh);
  for (int layer = 0; layer < DEPTH; ++layer) {
    if (layer > 0) xcd_barrier(xb);
    phase_conv(p, layer, smh);
    const bool need_ctx = layer < DEPTH - 1;
    const int Mres = need_ctx ? MH : ML;
    for (int g = 0; g < 2; ++g) {
      const float* hl = layer == 0 ? p.x : p.out;
      const float* hcx = layer == 0 ? p.ctx : p.hc;
      if (layer == 0 && g == 0) {
        grid.sync();
        phase_norm(p, 0, 0, 0, p.x, p.ctx, MH);
      }
      xcd_barrier(xb);
      phase_p1(p, smem);
      xcd_barrier(xb);
      phase_p2(p, layer, smh);
      xcd_barrier(xb);
      phase_p3(p, layer, need_ctx, smh, 0, P3_SPLIT);
      xcd_barrier(xb);
      phase_p3(p, layer, need_ctx, smh, P3_SPLIT, 1 << 30);
      xcd_barrier(xb);
      if (need_ctx) phase_p5x<9>(p, MH, smem); else phase_p5x<8>(p, ML, smem);
      xcd_barrier(xb);
      if (need_ctx) phase_res<9>(p, g, layer, p.mbuf, D, p.Wout, 2048, hl, hcx, MH, smem); else phase_res<8>(p, g, layer, p.mbuf, D, p.Wout, 2048, hl, hcx, ML, smem);
      xcd_barrier(xb);
      phase_norm(p, g, layer, 1, p.out, p.hc, Mres);
      xcd_barrier(xb);
      if (need_ctx) phase_p7<9>(p, MH, smem); else phase_p7<8>(p, ML, smem);
      xcd_barrier(xb);
      if (need_ctx) phase_res<9>(p, g, layer, p.act, FFH, p.Wfo, 5120, p.out, p.hc, MH, smem); else phase_res<8>(p, g, layer, p.act, FFH, p.Wfo, 5120, p.out, p.hc, ML, smem);
      if (g == 0) phase_norm(p, 1, layer, 0, hl, hcx, MH);
      else if (layer + 1 < DEPTH) phase_norm(p, 0, layer + 1, 0, p.out, p.hc, MH);
    }
  }
  xcd_barrier(xb);
  phase_final(p);
}

extern "C" void kernel_launch(void* const* d_in, const int* in_sizes, int n_in, void* d_out, int out_size, void* d_ws, size_t ws_size,
                              hipStream_t stream) {
  static int grid_blocks = 0;
  if (!grid_blocks) {
    int dev = 0, cus = 0, per_cu = 0;
    (void)hipGetDevice(&dev);
    (void)hipDeviceGetAttribute(&cus, hipDeviceAttributeMultiprocessorCount, dev);
    (void)hipFuncSetAttribute((const void*)fwd_megakernel, hipFuncAttributeMaxDynamicSharedMemorySize, DYN_LDS);
    (void)hipOccupancyMaxActiveBlocksPerMultiprocessor(&per_cu, fwd_megakernel, 512, DYN_LDS);
    if (per_cu > 1) per_cu = 1;
    if (per_cu < 1) per_cu = 1;
    grid_blocks = cus * per_cu;
  }
  P p{};
  const float** ip = (const float**)&p;
  for (int i = 0; i < 26; ++i) ip[i] = (const float*)d_in[i];
  p.out = (float*)d_out;
  unsigned char* w = (unsigned char*)d_ws;
  size_t off = 0;
  auto take = [&](size_t bytes) { unsigned char* r = w + off; off += (bytes + 255) & ~(size_t)255; return r; };
  p.WinA = (bf16_t*)take((size_t)ZN * D * 2);
  p.WinG = (bf16_t*)take((size_t)3072 * D * 2);
  p.Wq = (bf16_t*)take((size_t)768 * 384 * 2);
  p.Wkv = (bf16_t*)take((size_t)1024 * 256 * 2);
  p.Wa = (bf16_t*)take((size_t)D * 512 * 2);
  p.Wb = (bf16_t*)take((size_t)D * 512 * 2);
  p.Wc = (bf16_t*)take((size_t)D * 512 * 2);
  p.Wout = (bf16_t*)take((size_t)D * D * 2);
  p.Wfi = (bf16_t*)take((size_t)2 * FFH * D * 2);
  p.Wfo = (bf16_t*)take((size_t)D * FFH * 2);
  p.mod = (float*)take((size_t)DEPTH * 17 * 6144 * 4);
  p.ropec = (float*)take((size_t)SEQ * 16 * 4);
  p.ropes = (float*)take((size_t)SEQ * 16 * 4);
  p.hc = (float*)take((size_t)NBATCH * CTXL * D * 4);
  p.u = (bf16_t*)take((size_t)MH * D * 2);
  {
    const size_t zb = (size_t)MH * ZW * 2, ab = (size_t)MH * FFH * 2;
    unsigned char* r1 = take(zb > ab ? zb : ab);
    p.z = (bf16_t*)r1; p.act = (bf16_t*)r1;
  }
  {
    const size_t qb = (size_t)MH * 768 * 2, kb = (size_t)HB * 8 * KVP * 96 * 2;
    unsigned char* r2 = take(qb + kb);
    p.Qm = (bf16_t*)r2; p.Km = (bf16_t*)(r2 + qb); p.mbuf = (bf16_t*)r2;
  }
  p.Vtm = (bf16_t*)take((size_t)HB * 8 * 64 * KVP * 2);
  p.Vtn = (bf16_t*)take((size_t)HB * 8 * 64 * KVP * 2);
  p.Vtg = (bf16_t*)take((size_t)HB * 4 * 128 * KVP * 2);
  p.Sg = (bf16_t*)take((size_t)HB * 4 * 2 * 36 * 8192 * 2);
  p.dec = (float*)take((size_t)HB * 4 * 2 * 36 * 64 * 4);
  p.ya = (bf16_t*)take((size_t)MH * 512 * 2);
  p.yb = (bf16_t*)take((size_t)MH * 512 * 2);
  p.yc = (bf16_t*)take((size_t)MH * 512 * 2);
  p.bar = (unsigned*)take((size_t)XCD_BAR_WORDS * 4);
  if (off > ws_size) { fprintf(stderr, "workspace too small: need %zu have %zu\n", off, ws_size); return; }
  (void)hipMemsetAsync(p.bar, 0, (size_t)XCD_BAR_WORDS * 4, stream);
  void* args[] = {&p};
  hipError_t e = hipLaunchCooperativeKernel((void*)fwd_megakernel, dim3(grid_blocks), dim3(512), args, DYN_LDS, stream);
  if (e != hipSuccess) fprintf(stderr, "cooperative launch failed: %s (grid %d)\n", hipGetErrorString(e), grid_blocks);
}
```

```cpp
#include <hip/hip_runtime.h>
#include <hip/hip_cooperative_groups.h>
#include <stdint.h>
#include <cstdio>
namespace cg = cooperative_groups;

typedef unsigned short bf16_t;
typedef short bf16x8 __attribute__((ext_vector_type(8)));
typedef float f32x4 __attribute__((ext_vector_type(4)));
typedef unsigned u32x4 __attribute__((ext_vector_type(4)));
typedef unsigned u32x2 __attribute__((ext_vector_type(2)));
#define DEVI __device__ __forceinline__

constexpr int D = 1024, SEQ = 2048, CTXL = 256, DEPTH = 4, NBATCH = 16;
constexpr int HB = 8;
constexpr int ML = HB * SEQ;
constexpr int MC = HB * CTXL;
constexpr int MH = ML + MC;
constexpr int INW = 6848, FFH = 2816;
constexpr int KVP = SEQ + CTXL;
constexpr int ZQD = 0, ZKVD = 384, ZKR = 640, ZGQ = 672, ZGK = 928, ZGG = 1184, ZLRF = 1696, ZLRB = 1712, ZNQ = 1728, ZNK = 2240, ZW = 2752;
constexpr int ZN = 3840;
constexpr float EPS = 1e-6f;
constexpr float LOG2E = 1.4426950408889634f;

struct P {
  const float *x, *c, *ctx, *c_ctx, *w_mod, *b_mod, *norm1_w, *w_in, *qn_w, *kvn_w, *wq_up, *wkv_up, *wgf, *bgf, *wgb, *bgb, *gla_nw, *rpb,
      *w_a_o, *w_b_o, *w_c_o, *w_out, *norm2_w, *w_ffn_in, *w_ffn_out, *final_w;
  float* out;
  bf16_t *WinA, *WinG, *Wq, *Wkv, *Wa, *Wb, *Wc, *Wout, *Wfi, *Wfo;
  float *mod, *ropec, *ropes, *hc;
  bf16_t *hbl, *hbc;
  bf16_t *u, *z, *Qm, *Km, *Vtm, *Vtn, *Vtg;
  bf16_t* Sg;
  float* dec;
  bf16_t *ya, *yb, *yc, *mbuf, *act;
  unsigned* bar;
};

DEVI unsigned cvt_pk(float lo, float hi) { unsigned r; asm volatile("v_cvt_pk_bf16_f32 %0, %1, %2" : "=v"(r) : "v"(lo), "v"(hi)); return r; }
DEVI int otid8() { int t = threadIdx.x; asm volatile("" : "+v"(t)); return t; }
DEVI int otid() { return otid8() & 255; }
DEVI int osub() { return __builtin_amdgcn_readfirstlane(otid8() >> 8); }
DEVI int vbid() { return blockIdx.x * 2 + osub(); }
DEVI int vnb() { return gridDim.x * 2; }
DEVI float bf2f(bf16_t h) { return __uint_as_float(((unsigned)h) << 16); }
DEVI float bflo(unsigned w) { return __uint_as_float(w << 16); }
DEVI float bfhi(unsigned w) { return __uint_as_float(w & 0xffff0000u); }
DEVI bf16_t f2bf(float f) { return (bf16_t)(cvt_pk(f, 0.f) & 0xffffu); }
DEVI uint2 pack4(f32x4 v) { uint2 r; r.x = cvt_pk(v[0], v[1]); r.y = cvt_pk(v[2], v[3]); return r; }
DEVI float sigmoidf_(float x) { return __builtin_amdgcn_rcpf(1.f + __expf(-x)); }
DEVI f32x4 mfma16(bf16x8 a, bf16x8 b, f32x4 c) { return __builtin_amdgcn_mfma_f32_16x16x32_bf16(a, b, c, 0, 0, 0); }
DEVI float sumsq8(uint4 v) {
  float s = 0.f, t;
  t = bflo(v.x); s += t * t; t = bfhi(v.x); s += t * t; t = bflo(v.y); s += t * t; t = bfhi(v.y); s += t * t;
  t = bflo(v.z); s += t * t; t = bfhi(v.z); s += t * t; t = bflo(v.w); s += t * t; t = bfhi(v.w); s += t * t;
  return s;
}
DEVI float xrow16_max(float x) {
  auto s_ = __builtin_amdgcn_permlane16_swap(__float_as_uint(x), __float_as_uint(x), false, false);
  x = fmaxf(__uint_as_float(s_[0]), __uint_as_float(s_[1]));
  auto t_ = __builtin_amdgcn_permlane32_swap(__float_as_uint(x), __float_as_uint(x), false, false);
  return fmaxf(__uint_as_float(t_[0]), __uint_as_float(t_[1]));
}
DEVI void row_bp(int r, int& bl, int& pos) {
  if (r < ML) { bl = r >> 11; pos = r & 2047; } else { int rc = r - ML; bl = rc >> 8; pos = SEQ + (rc & 255); }
}


#define XB_TMO      128
#define XB_XCNT(j)  (256  + 64 * (j))
#define XB_XSUB(j)  (1280 + 64 * (j))
#define XB_XGEN(j)  (2304 + 64 * (j))
#define XB_TOP      3328
#define XB_TOPGEN   3392
#define XCD_BAR_WORDS 3456
#define XB_SPIN_CAP (1u << 22)
#define LAS __attribute__((address_space(3)))
DEVI unsigned xb_ld(unsigned* p) { return __hip_atomic_load(p, __ATOMIC_RELAXED, __HIP_MEMORY_SCOPE_AGENT); }
DEVI unsigned xb_add(unsigned* p, unsigned v) { return __hip_atomic_fetch_add(p, v, __ATOMIC_RELAXED, __HIP_MEMORY_SCOPE_AGENT); }
DEVI unsigned xb_xcc_id() { return (unsigned)__builtin_amdgcn_s_getreg((3 << 11) | 20) & 0xFu; }
#define XB_SPIN(cond, bar) do { unsigned _sp = 0; while (cond) { __builtin_amdgcn_s_sleep(1); \
    if ((++_sp & 255u) == 0u) { if (xb_ld(&(bar)[XB_TMO])) break; if (_sp > XB_SPIN_CAP) { atomicAdd(&(bar)[XB_TMO], 1u); break; } } } } while (0)
struct XcdBarrier { unsigned* bar; unsigned x; volatile LAS unsigned* st; };
DEVI XcdBarrier xcd_barrier_post(unsigned* bar, volatile LAS unsigned* st) {
  XcdBarrier b; b.bar = bar; b.x = xb_xcc_id(); b.st = st;
  if (threadIdx.x == 0) (void)xb_add(&bar[XB_XCNT(b.x)], 1u);
  return b;
}
DEVI void xcd_barrier_complete(unsigned* bar, unsigned x, unsigned& nloc, unsigned& nx) {
  const unsigned G = gridDim.x * gridDim.y * gridDim.z;
  unsigned sum, cnt, mine, sp = 0u;
  for (;;) {
    sum = 0u; cnt = 0u; mine = 0u;
#pragma unroll
    for (unsigned j = 0; j < 16; ++j) { const unsigned c = xb_ld(&bar[XB_XCNT(j)]); sum += c; cnt += (c > 0u) ? 1u : 0u; mine = (j == x) ? c : mine; }
    if (sum == G) break;
    __builtin_amdgcn_s_sleep(1);
    if ((++sp & 255u) == 0u) { if (xb_ld(&bar[XB_TMO])) break; if (sp > XB_SPIN_CAP) { atomicAdd(&bar[XB_TMO], 1u); break; } }
  }
  nloc = mine > 0u ? mine : 1u; nx = cnt > 0u ? cnt : 1u;
}
DEVI void xcd_barrier(const XcdBarrier& b) {
  asm volatile("s_waitcnt vmcnt(0)" ::: "memory");
  __syncthreads();
  if (threadIdx.x == 0) {
    unsigned* bar = b.bar;
    __builtin_amdgcn_s_waitcnt(0);
    unsigned nloc = b.st[0], nx = b.st[1];
    if (nloc == 0u) { xcd_barrier_complete(bar, b.x, nloc, nx); b.st[0] = nloc; b.st[1] = nx; }
    const unsigned old = xb_add(&bar[XB_XSUB(b.x)], 1u);
    const unsigned gen = old / nloc;
    if (old + 1u == (gen + 1u) * nloc) {
      __builtin_amdgcn_fence(__ATOMIC_RELEASE, "agent");
      asm volatile("s_waitcnt vmcnt(0)" ::: "memory");
      const unsigned og = xb_add(&bar[XB_TOP], 1u);
      const unsigned tg = og / nx;
      if (og + 1u == (tg + 1u) * nx) xb_add(&bar[XB_TOPGEN], 1u);
      else XB_SPIN(xb_ld(&bar[XB_TOPGEN]) == tg, bar);
      __builtin_amdgcn_fence(__ATOMIC_ACQUIRE, "agent");
      xb_add(&bar[XB_XGEN(b.x)], 1u);
      asm volatile("s_waitcnt vmcnt(0)" ::: "memory");
    } else {
      XB_SPIN(xb_ld(&bar[XB_XGEN(b.x)]) == gen, bar);
      __builtin_amdgcn_fence(__ATOMIC_ACQUIRE, "agent");
      asm volatile("s_waitcnt vmcnt(0)" ::: "memory");
    }
  }
  __syncthreads();
}

template <int N> DEVI void waitv() { asm volatile("s_waitcnt vmcnt(%0)" ::"n"(N) : "memory"); }
template <int MI>
DEVI void gemm_dma(const bf16_t* __restrict__ A, int lda, const bf16_t* __restrict__ Bt, int ldb, int K, f32x4 (&acc)[MI][4], unsigned char* smem) {
  constexpr int BM = MI * 32;
  constexpr int AF = MI / 2, AH = MI & 1;
  constexpr int STAGE = (BM + 128) * 64;
  const int tid = otid(), lane = tid & 63, wave = tid >> 6, wm = wave >> 1, wn = wave & 1;
  const int lr = tid >> 2, lc = (tid & 3) ^ ((-((lr >> 2) & 3)) & 3);
  const int fr = lane & 15, fq = lane >> 4;
  const int rofs = fr * 64 + ((fq ^ ((-((fr >> 2) & 3)) & 3)) * 16);
  const bf16_t* ag = A + (size_t)lr * lda + lc * 8;
  const bf16_t* bg = Bt + (size_t)lr * ldb + lc * 8;
  unsigned char* ldst = smem + tid * 16;
  const bool lowhalf = wave < 2;
#pragma unroll
  for (int mi = 0; mi < MI; ++mi)
#pragma unroll
    for (int ni = 0; ni < 4; ++ni) acc[mi][ni] = (f32x4){0.f, 0.f, 0.f, 0.f};
  asm volatile("s_waitcnt vmcnt(0)" ::: "memory");
  __syncthreads();
#define DMA_ISSUE(stage_, kt_)                                                                                                        \
  {                                                                                                                                   \
    unsigned char* sb_ = ldst + (stage_) * STAGE;                                                                                     \
    const int ko_ = (kt_) * 32;                                                                                                       \
    _Pragma("unroll") for (int i = 0; i < AF; ++i)                                                                                    \
        __builtin_amdgcn_global_load_lds((const unsigned*)(ag + (size_t)(64 * i) * lda + ko_), (LAS unsigned*)(sb_ + i * 4096), 16, 0, 0); \
    if (AH && lowhalf)                                                                                                                \
      __builtin_amdgcn_global_load_lds((const unsigned*)(ag + (size_t)(64 * AF) * lda + ko_), (LAS unsigned*)(sb_ + AF * 4096), 16, 0, 0); \
    _Pragma("unroll") for (int i = 0; i < 2; ++i)                                                                                     \
        __builtin_amdgcn_global_load_lds((const unsigned*)(bg + (size_t)(64 * i) * ldb + ko_), (LAS unsigned*)(sb_ + BM * 64 + i * 4096), 16, 0, 0); \
  }
  const int nk = K >> 5;
  DMA_ISSUE(0, 0)
  if (nk > 1) DMA_ISSUE(1, 1)
  int st = 0, st2 = 2;
  for (int kt = 0; kt < nk; ++kt) {
    if (kt + 1 < nk) { if (AH && lowhalf) waitv<AF + 3>(); else waitv<AF + 2>(); }
    else waitv<0>();
    __builtin_amdgcn_s_barrier();
    if (kt + 2 < nk) DMA_ISSUE(st2, kt + 2)
    const unsigned char* Ac = smem + st * STAGE + (wm * MI * 16) * 64 + rofs;
    const unsigned char* Bc = smem + st * STAGE + BM * 64 + (wn * 64) * 64 + rofs;
    bf16x8 bfr[4];
#pragma unroll
    for (int ni = 0; ni < 4; ++ni) bfr[ni] = *(const bf16x8*)(Bc + ni * 1024);
    bf16x8 af[MI];
#pragma unroll
    for (int mi = 0; mi < MI; ++mi) af[mi] = *(const bf16x8*)(Ac + mi * 1024);
#pragma unroll
    for (int mi = 0; mi < MI; ++mi) {
#pragma unroll
      for (int ni = 0; ni < 4; ++ni) acc[mi][ni] = mfma16(bfr[ni], af[mi], acc[mi][ni]);
    }
    __builtin_amdgcn_sched_group_barrier(0x100, 6, 0);
#pragma unroll
    for (int mi = 0; mi < MI; ++mi) {
      __builtin_amdgcn_sched_group_barrier(0x008, 4, 0);
      if (mi + 2 < MI) __builtin_amdgcn_sched_group_barrier(0x100, 1, 0);
    }
    st = (st == 2) ? 0 : st + 1;
    st2 = (st2 == 2) ? 0 : st2 + 1;
  }
  __syncthreads();
}


template <int MI>
DEVI void gemm_dma8(const bf16_t* __restrict__ A, int lda, const bf16_t* __restrict__ Bt, int ldb, int K, f32x4 (&acc)[MI][4], unsigned char* smem) {
  constexpr int BM = MI * 32;
  static_assert(MI == 8 || MI == 9, "gemm_dma8: MI is 8 or 9");
  constexpr bool ODD = (MI == 9);
  constexpr int STAGE = (BM + 256) * 64;
  const int tid = otid8(), lane = tid & 63, wave = __builtin_amdgcn_readfirstlane(tid >> 6), wm = wave >> 2, wn = wave & 3;
  const int lr = tid >> 2, lc = (tid & 3) ^ ((-((lr >> 2) & 3)) & 3);
  const int fr = lane & 15, fq = lane >> 4;
  const int rofs = fr * 64 + ((fq ^ ((-((fr >> 2) & 3)) & 3)) * 16);
  const bf16_t* ag = A + (size_t)lr * lda + lc * 8;
  const bf16_t* bg = Bt + (size_t)lr * ldb + lc * 8;
  unsigned char* ldst = smem + wave * 1024;
  const bool extra = ODD && (wave < 2);
#pragma unroll
  for (int mi = 0; mi < MI; ++mi)
#pragma unroll
    for (int ni = 0; ni < 4; ++ni) acc[mi][ni] = (f32x4){0.f, 0.f, 0.f, 0.f};
  asm volatile("s_waitcnt vmcnt(0)" ::: "memory");
  __syncthreads();
#define DMA8_ISSUE(stage_, kt_)                                                                                                       \
  {                                                                                                                                   \
    unsigned char* sb_ = ldst + (stage_) * STAGE;                                                                                     \
    const int ko_ = (kt_) * 32;                                                                                                       \
    _Pragma("unroll") for (int i = 0; i < 2; ++i)                                                                                     \
        __builtin_amdgcn_global_load_lds((const unsigned*)(ag + (size_t)(128 * i) * lda + ko_), (LAS unsigned*)(sb_ + i * 8192), 16, 0, 0); \
    if (extra)                                                                                                                        \
      __builtin_amdgcn_global_load_lds((const unsigned*)(ag + (size_t)256 * lda + ko_), (LAS unsigned*)(sb_ + 16384), 16, 0, 0);      \
    _Pragma("unroll") for (int i = 0; i < 2; ++i)                                                                                     \
        __builtin_amdgcn_global_load_lds((const unsigned*)(bg + (size_t)(128 * i) * ldb + ko_), (LAS unsigned*)(sb_ + BM * 64 + i * 8192), 16, 0, 0); \
  }
#define WAIT_NEXT(kt_)                                                                  \
  {                                                                                     \
    if ((kt_) + 3 < nk) { if (extra) waitv<10>(); else waitv<8>(); }                    \
    else if ((kt_) + 2 < nk) { if (extra) waitv<5>(); else waitv<4>(); }                \
    else waitv<0>();                                                                    \
  }
  const int nk = K >> 5;
  DMA8_ISSUE(0, 0)
  DMA8_ISSUE(1, 1)
  DMA8_ISSUE(2, 2)
  if (extra) waitv<10>(); else waitv<8>();
  __builtin_amdgcn_s_barrier();
  if (wm == 1) __builtin_amdgcn_s_barrier();
  __builtin_amdgcn_sched_barrier(0);
  for (int kt = 0; kt < nk; ++kt) {
    const int st = kt & 3;
    if (kt + 3 < nk) DMA8_ISSUE((kt + 3) & 3, kt + 3)
    const unsigned char* Ac = smem + st * STAGE + (wm * MI * 16) * 64 + rofs;
    const unsigned char* Bc = smem + st * STAGE + BM * 64 + (wn * 64) * 64 + rofs;
    bf16x8 bfr[4], af[MI];
#pragma unroll
    for (int ni = 0; ni < 4; ++ni) bfr[ni] = *(const bf16x8*)(Bc + ni * 1024);
#pragma unroll
    for (int mi = 0; mi < MI; ++mi) af[mi] = *(const bf16x8*)(Ac + mi * 1024);
    if (wm == 1) {
      WAIT_NEXT(kt)
      asm volatile("s_waitcnt lgkmcnt(0)" ::: "memory");
    }
    __builtin_amdgcn_sched_barrier(0);
    __builtin_amdgcn_s_barrier();
    __builtin_amdgcn_sched_barrier(0);
#pragma unroll
    for (int mi = 0; mi < MI; ++mi) {
#pragma unroll
      for (int ni = 0; ni < 4; ++ni) acc[mi][ni] = mfma16(bfr[ni], af[mi], acc[mi][ni]);
    }
    if (wm == 0) WAIT_NEXT(kt)
    __builtin_amdgcn_sched_barrier(0);
    __builtin_amdgcn_s_barrier();
    __builtin_amdgcn_sched_barrier(0);
  }
  if (wm == 0) __builtin_amdgcn_s_barrier();
  __syncthreads();
}
#define FOR_ACC8(MI_, ACC_, ...)                                                                 \
  {                                                                                              \
    const int t__ = otid8(), l__ = t__ & 63, w__ = t__ >> 6, wm__ = w__ >> 2, wn__ = w__ & 3;    \
    _Pragma("unroll") for (int mi = 0; mi < MI_; ++mi) {                                         \
      _Pragma("unroll") for (int ni = 0; ni < 4; ++ni) {                                         \
        const int m = wm__ * MI_ * 16 + mi * 16 + (l__ & 15), n = wn__ * 64 + ni * 16 + (l__ >> 4) * 4; \
        f32x4 v = ACC_[mi][ni];                                                                  \
        __VA_ARGS__                                                                              \
      }                                                                                          \
    }                                                                                            \
  }

DEVI void row_rstd128(const bf16_t* __restrict__ A, int lda, int K, float* rs_out) {
  const int tid = otid(), row = tid >> 1, half = tid & 1;
  const bf16_t* ap = A + (size_t)row * lda + half * (K >> 1);
  float s = 0.f;
#pragma unroll 4
  for (int k = 0; k < (K >> 1); k += 8) s += sumsq8(*(const uint4*)(ap + k));
  s += __shfl_xor(s, 1);
  if (half == 0) rs_out[row] = rsqrtf(s / (float)K + EPS);
}

#define FOR_ACC(MI_, ACC_, ...)                                                                  \
  {                                                                                              \
    const int t__ = otid(), l__ = t__ & 63, w__ = t__ >> 6, wm__ = w__ >> 1, wn__ = w__ & 1;     \
    _Pragma("unroll") for (int mi = 0; mi < MI_; ++mi) {                                         \
      _Pragma("unroll") for (int ni = 0; ni < 4; ++ni) {                                         \
        const int m = wm__ * MI_ * 16 + mi * 16 + (l__ & 15), n = wn__ * 64 + ni * 16 + (l__ >> 4) * 4; \
        f32x4 v = ACC_[mi][ni];                                                                  \
        __VA_ARGS__                                                                              \
      }                                                                                          \
    }                                                                                            \
  }

DEVI int map_col(int map, int n, int off) {
  if (map == 0) return n + off;
  if (map == 1) {
    if (n < 1184) return n;
    if (n < 1696) return n - 1184 + 1696;
    if (n < 1728) return n - 1696 + 2208;
    if (n < 2752) return n - 1728 + 2240;
    if (n < 2816) return -1;
    if (n < 3328) return n - 2816 + 1184;
    return n - 3328 + 3264;
  }
  const int tile = n >> 8, p = n & 255, wn = p >> 6, sub = (p >> 5) & 1, i = p & 31;
  return sub * FFH + tile * 128 + wn * 32 + i;
}
DEVI void convT(const float* __restrict__ src, int ld, int K, int N, bf16_t* __restrict__ dst, const float* __restrict__ kscale, int map, int off,
                unsigned char* smem) {
  float* tile = (float*)smem;
  const int tid = otid();
  const int tk = K >> 6, tn = N >> 6, nt = tk * tn;
  for (int it = vbid(); it < nt; it += vnb()) {
    const int k0 = (it % tk) * 64, n0 = (it / tk) * 64;
    __syncthreads();
    const int nn = tid & 63;
    const int sc = map_col(map, n0 + nn, off);
#pragma unroll
    for (int i = 0; i < 16; ++i) {
      const int kk = i * 4 + (tid >> 6);
      float v = 0.f;
      if (sc >= 0) { v = src[(size_t)(k0 + kk) * ld + sc]; if (kscale) v *= kscale[k0 + kk]; }
      tile[kk * 65 + nn] = v;
    }
    __syncthreads();
    const int n = tid >> 2, kc = tid & 3;
    unsigned w[8];
#pragma unroll
    for (int i = 0; i < 8; ++i) w[i] = cvt_pk(tile[(kc * 16 + 2 * i) * 65 + n], tile[(kc * 16 + 2 * i + 1) * 65 + n]);
    uint4* dp = (uint4*)(dst + (size_t)(n0 + n) * K + k0 + kc * 16);
    dp[0] = make_uint4(w[0], w[1], w[2], w[3]);
    dp[1] = make_uint4(w[4], w[5], w[6], w[7]);
  }
}
DEVI void phase_conv(const P& p, int l, unsigned char* smem) {
  convT(p.w_in + (size_t)l * D * INW, INW, D, ZN, p.WinA, nullptr, 1, 0, smem);
  convT(p.w_in + (size_t)l * D * INW, INW, D, 3072, p.WinG, nullptr, 0, 3776, smem);
  convT(p.wq_up + (size_t)l * 384 * 768, 768, 384, 768, p.Wq, p.qn_w + l * 384, 0, 0, smem);
  convT(p.wkv_up + (size_t)l * 256 * 1024, 1024, 256, 1024, p.Wkv, p.kvn_w + l * 256, 0, 0, smem);
  convT(p.w_a_o + (size_t)l * 512 * D, D, 512, D, p.Wa, nullptr, 0, 0, smem);
  convT(p.w_b_o + (size_t)l * 512 * D, D, 512, D, p.Wb, nullptr, 0, 0, smem);
  convT(p.w_c_o + (size_t)l * 512 * D, D, 512, D, p.Wc, nullptr, 0, 0, smem);
  convT(p.w_out + (size_t)l * D * D, D, D, D, p.Wout, nullptr, 0, 0, smem);
  convT(p.w_ffn_in + (size_t)l * D * 2 * FFH, 2 * FFH, D, 2 * FFH, p.Wfi, nullptr, 2, 0, smem);
  convT(p.w_ffn_out + (size_t)l * FFH * D, D, FFH, D, p.Wfo, nullptr, 0, 0, smem);
}

DEVI void phase_prep(const P& p, unsigned char* smem) {
  const int tid = otid();
  float* cact = (float*)smem;
  float* red = (float*)(smem + 40960);
  for (int it = vbid(); it < 4 * 96; it += vnb()) {
    const int l = it / 96, n0 = (it % 96) * 64;
    const int col = tid & 63, kg = tid >> 6;
    float acc[17];
#pragma unroll
    for (int b = 0; b < 17; ++b) acc[b] = 0.f;
    for (int pass = 0; pass < 2; ++pass) {
      __syncthreads();
      for (int e = tid; e < 512 * 17; e += 256) {
        const int kk = e & 511, b = e >> 9;
        const float v = (b < 16) ? p.c[b * D + pass * 512 + kk] : p.c_ctx[pass * 512 + kk];
        cact[kk * 20 + b] = v / (1.f + __expf(-v));
      }
      __syncthreads();
      const float* wp = p.w_mod + ((size_t)l * D + pass * 512 + kg * 128) * 6144 + n0 + col;
#pragma unroll 16
      for (int k = 0; k < 128; ++k) {
        const float w = wp[(size_t)k * 6144];
        const float* cp = cact + (kg * 128 + k) * 20;
#pragma unroll
        for (int b = 0; b < 17; ++b) acc[b] += cp[b] * w;
      }
    }
#pragma unroll
    for (int b = 0; b < 17; ++b) red[(kg * 17 + b) * 64 + col] = acc[b];
    __syncthreads();
    for (int e = tid; e < 17 * 64; e += 256) {
      const int b = e >> 6, cc = e & 63;
      const float v = red[(0 * 17 + b) * 64 + cc] + red[(1 * 17 + b) * 64 + cc] + red[(2 * 17 + b) * 64 + cc] + red[(3 * 17 + b) * 64 + cc];
      p.mod[((size_t)l * 17 + b) * 6144 + n0 + cc] = v + p.b_mod[l * 6144 + n0 + cc];
    }
  }
  for (int e = vbid() * 256 + tid; e < SEQ * 16; e += vnb() * 256) {
    const int t = e >> 4, j = e & 15, f = j & 7;
    const float pos = (j < 8) ? (float)(t >> 6) : (float)(t & 63);
    const float inv = powf(10000.0f, -(float)f / 8.0f);
    const float ang = pos * inv;
    p.ropec[e] = cosf(ang);
    p.ropes[e] = sinf(ang);
  }
}

DEVI void phase_norm(const P& p, int g, int layer, int which, const float* hl, const float* hcx, int Mrows) {
  const int tid = otid(), lane = tid & 63, wave = tid >> 6;
  const float* nw = (which ? p.norm2_w : p.norm1_w) + layer * D;
  const int stride = vnb() * 4;
  for (int r0 = vbid() * 4 + wave; r0 < Mrows; r0 += 2 * stride) {
    const int r1 = r0 + stride;
    const bool has1 = r1 < Mrows;
    const int rr1 = has1 ? r1 : r0;
    const size_t o0 = (r0 < ML) ? ((size_t)g * ML + r0) * D : ((size_t)g * MC + (r0 - ML)) * D;
    const size_t o1 = (rr1 < ML) ? ((size_t)g * ML + rr1) * D : ((size_t)g * MC + (rr1 - ML)) * D;
    f32x4 v0[4], v1[4];
    if (hl) {
      const float* h0 = ((r0 < ML) ? hl : hcx) + o0;
      const float* h1 = ((rr1 < ML) ? hl : hcx) + o1;
#pragma unroll
      for (int i = 0; i < 4; ++i) { v0[i] = *(const f32x4*)(h0 + i * 256 + lane * 4); v1[i] = *(const f32x4*)(h1 + i * 256 + lane * 4); }
    } else {
      const bf16_t* h0 = ((r0 < ML) ? p.hbl : p.hbc) + o0;
      const bf16_t* h1 = ((rr1 < ML) ? p.hbl : p.hbc) + o1;
      u32x2 w0[4], w1[4];
#pragma unroll
      for (int i = 0; i < 4; ++i) { w0[i] = *(const u32x2*)(h0 + i * 256 + lane * 4); w1[i] = *(const u32x2*)(h1 + i * 256 + lane * 4); }
#pragma unroll
      for (int i = 0; i < 4; ++i) {
        v0[i] = (f32x4){bflo(w0[i][0]), bfhi(w0[i][0]), bflo(w0[i][1]), bfhi(w0[i][1])};
        v1[i] = (f32x4){bflo(w1[i][0]), bfhi(w1[i][0]), bflo(w1[i][1]), bfhi(w1[i][1])};
      }
    }
    float s0 = 0.f, s1 = 0.f;
#pragma unroll
    for (int i = 0; i < 4; ++i) {
      s0 += v0[i][0] * v0[i][0] + v0[i][1] * v0[i][1] + v0[i][2] * v0[i][2] + v0[i][3] * v0[i][3];
      s1 += v1[i][0] * v1[i][0] + v1[i][1] * v1[i][1] + v1[i][2] * v1[i][2] + v1[i][3] * v1[i][3];
    }
#pragma unroll
    for (int o = 1; o < 64; o <<= 1) { s0 += __shfl_xor(s0, o); s1 += __shfl_xor(s1, o); }
    const float rstd0 = rsqrtf(s0 * (1.f / D) + EPS), rstd1 = rsqrtf(s1 * (1.f / D) + EPS);
#pragma unroll
    for (int k = 0; k < 2; ++k) {
      if (k == 1 && !has1) break;
      const int r = k ? r1 : r0;
      const float rstd = k ? rstd1 : rstd0;
      const int b = (r < ML) ? g * HB + (r >> 11) : 16;
      const float* md = p.mod + ((size_t)layer * 17 + b) * 6144;
      const float* sh = md + (which ? 3072 : 0);
      const float* sc = md + (which ? 4096 : 1024);
      bf16_t* up = p.u + (size_t)r * D;
#pragma unroll
      for (int i = 0; i < 4; ++i) {
        const int c0 = i * 256 + lane * 4;
        const float4 w4 = *(const float4*)(nw + c0), s4 = *(const float4*)(sc + c0), h4 = *(const float4*)(sh + c0);
        const f32x4 v = k ? v1[i] : v0[i];
        f32x4 o;
        o[0] = v[0] * rstd * w4.x * (1.f + s4.x) + h4.x;
        o[1] = v[1] * rstd * w4.y * (1.f + s4.y) + h4.y;
        o[2] = v[2] * rstd * w4.z * (1.f + s4.z) + h4.z;
        o[3] = v[3] * rstd * w4.w * (1.f + s4.w) + h4.w;
        *(uint2*)(up + c0) = pack4(o);
      }
    }
  }
}

DEVI void phase_p1(const P& p, unsigned char* smem) {
  constexpr int MT = MH / 288, NT = ZN / 256;
  for (int it = blockIdx.x; it < MT * NT; it += gridDim.x) {
    const int mt = it % MT, nt = it / MT;
    const int m0 = mt * 288, n0 = nt * 256;
    f32x4 acc[9][4];
    gemm_dma8<9>(p.u + (size_t)m0 * D, D, p.WinA + (size_t)n0 * D, D, D, acc, smem);
    if (n0 < 2816) {
      FOR_ACC8(9, acc, {
        const int nn = n0 + n;
        if (nn >= ZNQ && nn < ZNQ + 512) v = v * (0.125f * LOG2E);
        if (nn < ZW) *(uint2*)(p.z + (size_t)(m0 + m) * ZW + nn) = pack4(v);
      })
    } else {
      FOR_ACC8(9, acc, {
        int bl, pos;
        row_bp(m0 + m, bl, pos);
        const int n1 = n0 + n - 2816;
        bf16_t* dst;
        if (n1 < 512) dst = p.Vtg + ((size_t)(bl * 4 + (n1 >> 7)) * 128 + (n1 & 127)) * KVP + pos;
        else { const int n2 = n1 - 512; dst = p.Vtn + ((size_t)(bl * 8 + (n2 >> 6)) * 64 + (n2 & 63)) * KVP + pos; }
        _Pragma("unroll") for (int j = 0; j < 4; ++j) dst[(size_t)j * KVP] = f2bf(v[j]);
      })
    }
  }
}

DEVI void gla_cum(const float* lrs, const float* __restrict__ wg, const float* __restrict__ bgp, int h, bool rev, float* tot, float (&cum)[16], float& last) {
  const int tid = otid(), d = tid & 63, tq = tid >> 6;
  float w[16];
#pragma unroll
  for (int k = 0; k < 16; ++k) w[k] = wg[k * 256 + h * 64 + d];
  const float b = bgp[h * 64 + d];
  float la[16];
#pragma unroll
  for (int i = 0; i < 16; ++i) {
    const float* lp = lrs + (tq * 16 + i) * 16;
    float zz = b;
#pragma unroll
    for (int k = 0; k < 16; ++k) zz += lp[k] * w[k];
    const float ls = fminf(zz, 0.f) - __logf(1.f + __expf(-fabsf(zz)));
    la[i] = ls * (1.f / 16.f);
  }
  float run = 0.f;
  if (!rev) {
#pragma unroll
    for (int i = 0; i < 16; ++i) { run += la[i]; cum[i] = run; }
  } else {
#pragma unroll
    for (int i = 15; i >= 0; --i) { run += la[i]; cum[i] = run; }
  }
  tot[tq * 64 + d] = run;
  __syncthreads();
  float off = 0.f, all = 0.f;
#pragma unroll
  for (int q2 = 0; q2 < 4; ++q2) {
    const float tv = tot[q2 * 64 + d];
    all += tv;
    const bool before = rev ? (q2 > tq) : (q2 < tq);
    if (before) off += tv;
  }
#pragma unroll
  for (int i = 0; i < 16; ++i) cum[i] += off;
  last = all;
  __syncthreads();
}

DEVI int gla_seq_index(int dir, int tc) { return dir == 0 ? tc : (tc < 4 ? 3 - tc : 39 - tc); }

DEVI void gla_g1_item(const P& p, int layer, int item, unsigned char* smem) {
  const int tc = item % 36, dir = (item / 36) & 1, h = (item / 72) & 3, bl = item / 288;
  const int tid = otid(), lane = tid & 63, wave = tid >> 6, d = tid & 63, tq = tid >> 6;
  const int fr = lane & 15, fq = lane >> 4;
  const int row0 = tc < 4 ? ML + bl * 256 + tc * 64 : bl * 2048 + (tc - 4) * 64;
  const int pos0 = tc < 4 ? SEQ + tc * 64 : (tc - 4) * 64;
  float* lrs = (float*)smem;
  float* tot = (float*)(smem + 8192);
  unsigned char* ke = smem + 10240;
  float lrv[4], kraw[16];
#pragma unroll
  for (int i = 0; i < 4; ++i) {
    const int e = tid + 256 * i, t = e >> 4, k = e & 15;
    lrv[i] = bf2f(p.z[(size_t)(row0 + t) * ZW + (dir ? ZLRB : ZLRF) + k]);
  }
#pragma unroll
  for (int i = 0; i < 16; ++i) kraw[i] = bf2f(p.z[(size_t)(row0 + tq * 16 + i) * ZW + ZGK + h * 64 + d]);
  bf16x8 vf[2][2];
#pragma unroll
  for (int ks = 0; ks < 2; ++ks)
#pragma unroll
    for (int a = 0; a < 2; ++a)
      vf[ks][a] = *(const bf16x8*)(p.Vtg + ((size_t)(bl * 4 + h) * 128 + (wave * 2 + a) * 16 + fr) * KVP + pos0 + ks * 32 + fq * 8);
  __syncthreads();
#pragma unroll
  for (int i = 0; i < 4; ++i) lrs[tid + 256 * i] = lrv[i];
  __syncthreads();
  float cum[16], last;
  gla_cum(lrs, (dir ? p.wgb : p.wgf) + layer * 16 * 256, (dir ? p.bgb : p.bgf) + layer * 256, h, dir != 0, tot, cum, last);
  unsigned w[8];
#pragma unroll
  for (int i = 0; i < 8; ++i) {
    const float k0 = kraw[2 * i] * __expf(last - cum[2 * i]);
    const float k1 = kraw[2 * i + 1] * __expf(last - cum[2 * i + 1]);
    w[i] = cvt_pk(k0, k1);
  }
  *(uint4*)(ke + d * 128 + (((tq * 2) ^ (d & 7)) * 16)) = make_uint4(w[0], w[1], w[2], w[3]);
  *(uint4*)(ke + d * 128 + (((tq * 2 + 1) ^ (d & 7)) * 16)) = make_uint4(w[4], w[5], w[6], w[7]);
  const int n = gla_seq_index(dir, tc);
  const size_t sidx = (size_t)((bl * 4 + h) * 2 + dir) * 36 + n;
  if (tq == 0) p.dec[sidx * 64 + d] = __expf(last);
  __syncthreads();
  f32x4 acc[2][4];
#pragma unroll
  for (int a = 0; a < 2; ++a)
#pragma unroll
    for (int b = 0; b < 4; ++b) acc[a][b] = (f32x4){0.f, 0.f, 0.f, 0.f};
#pragma unroll
  for (int ks = 0; ks < 2; ++ks) {
    bf16x8 kf[4];
#pragma unroll
    for (int b = 0; b < 4; ++b) kf[b] = *(const bf16x8*)(ke + (b * 16 + fr) * 128 + (((ks * 4 + fq) ^ (fr & 7)) * 16));
#pragma unroll
    for (int a = 0; a < 2; ++a)
#pragma unroll
      for (int b = 0; b < 4; ++b) acc[a][b] = mfma16(kf[b], vf[ks][a], acc[a][b]);
  }
  bf16_t* sp = p.Sg + sidx * 8192;
#pragma unroll
  for (int a = 0; a < 2; ++a)
#pragma unroll
    for (int b = 0; b < 4; ++b) *(uint2*)(sp + ((wave * 2 + a) * 16 + fr) * 64 + b * 16 + fq * 4) = pack4(acc[a][b]);
}

DEVI void gla_scan_item(const P& p, int item) {
  const int bhd = item >> 4, w = (item & 15) * 256 + otid();
  unsigned* base = (unsigned*)(p.Sg + (size_t)bhd * 36 * 8192) + w;
  const float* dp = p.dec + (size_t)bhd * 36 * 64 + (w & 31) * 2;
  unsigned kv[36];
  float dcx[36], dcy[36];
#pragma unroll
  for (int n = 0; n < 36; ++n) {
    kv[n] = base[(size_t)n * 4096];
    const float2 dc = *(const float2*)(dp + n * 64);
    dcx[n] = dc.x; dcy[n] = dc.y;
  }
  float s0 = 0.f, s1 = 0.f;
#pragma unroll
  for (int n = 0; n < 36; ++n) {
    base[(size_t)n * 4096] = cvt_pk(s0, s1);
    s0 = dcx[n] * s0 + bflo(kv[n]);
    s1 = dcy[n] * s1 + bfhi(kv[n]);
  }
}

DEVI void gla_g3_item(const P& p, int layer, int item, unsigned char* smem) {
  const int tc = item % 36, h = (item / 36) & 3, bl = item / 144;
  const int tid = otid(), lane = tid & 63, wave = tid >> 6, d = tid & 63, tq = tid >> 6;
  const int fr = lane & 15, fq = lane >> 4;
  const int row0 = tc < 4 ? ML + bl * 256 + tc * 64 : bl * 2048 + (tc - 4) * 64;
  const int pos0 = tc < 4 ? SEQ + tc * 64 : (tc - 4) * 64;
  float* lrs = (float*)smem;
  float* tot = (float*)(smem + 8192);
  unsigned char* qd = smem + 10240;
  unsigned char* ki = smem + 18432;
  unsigned char* st = smem + 26624;
  unsigned char* vt = smem + 43008;
  float lrv[8], qraw[16], kraw[16];
#pragma unroll
  for (int i = 0; i < 8; ++i) {
    const int e = tid + 256 * i, t = (e >> 5), k = e & 31;
    lrv[i] = bf2f(p.z[(size_t)(row0 + t) * ZW + ZLRF + k]);
  }
  u32x4 vtr[4];
#pragma unroll
  for (int i = 0; i < 4; ++i) {
    const int id = tid + 256 * i, row = id >> 3, ch = id & 7;
    vtr[i] = *(const u32x4*)(p.Vtg + ((size_t)(bl * 4 + h) * 128 + row) * KVP + pos0 + ch * 8);
  }
#pragma unroll
  for (int i = 0; i < 16; ++i) {
    const bf16_t* zr = p.z + (size_t)(row0 + tq * 16 + i) * ZW + h * 64 + d;
    qraw[i] = bf2f(zr[ZGQ]);
    kraw[i] = bf2f(zr[ZGK]);
  }
  u32x4 sg0[4], sg1[4];
  {
    const bf16_t* sp0 = p.Sg + ((size_t)((bl * 4 + h) * 2 + 0) * 36 + gla_seq_index(0, tc)) * 8192;
    const bf16_t* sp1 = p.Sg + ((size_t)((bl * 4 + h) * 2 + 1) * 36 + gla_seq_index(1, tc)) * 8192;
#pragma unroll
    for (int i = 0; i < 4; ++i) {
      const int id = tid + 256 * i, e = id >> 3, ch = id & 7;
      sg0[i] = *(const u32x4*)(sp0 + e * 64 + ch * 8);
      sg1[i] = *(const u32x4*)(sp1 + e * 64 + ch * 8);
    }
  }
  const int row = row0 + wave * 16 + fr;
  u32x2 gw[8];
#pragma unroll
  for (int eb = 0; eb < 8; ++eb) gw[eb] = *(const u32x2*)(p.z + (size_t)row * ZW + ZGG + h * 128 + eb * 16 + fq * 4);
  __syncthreads();
#pragma unroll
  for (int i = 0; i < 8; ++i) {
    const int e = tid + 256 * i, t = (e >> 5), k = e & 31;
    lrs[(k >> 4) * 1024 + t * 16 + (k & 15)] = lrv[i];
  }
#pragma unroll
  for (int i = 0; i < 4; ++i) {
    const int id = tid + 256 * i, rw = id >> 3, ch = id & 7;
    *(u32x4*)(vt + rw * 128 + ((ch ^ ((rw >> 1) & 7)) * 16)) = vtr[i];
  }
  f32x4 o[8];
#pragma unroll
  for (int eb = 0; eb < 8; ++eb) o[eb] = (f32x4){0.f, 0.f, 0.f, 0.f};
#pragma unroll
  for (int dir = 0; dir < 2; ++dir) {
    __syncthreads();
    float cum[16], last;
    gla_cum(lrs + dir * 1024, (dir ? p.wgb : p.wgf) + layer * 16 * 256, (dir ? p.bgb : p.bgf) + layer * 256, h, dir != 0, tot, cum, last);
#pragma unroll
    for (int i = 0; i < 16; ++i) {
      const int t = tq * 16 + i;
      const float qv = qraw[i] * 0.125f * __expf(cum[i]);
      const float kv = kraw[i] * __expf(-cum[i]);
      const int so = t * 128 + (((d >> 3) ^ (t & 7)) * 16) + (d & 7) * 2;
      *(bf16_t*)(qd + so) = f2bf(qv);
      *(bf16_t*)(ki + so) = f2bf(kv);
    }
#pragma unroll
    for (int i = 0; i < 4; ++i) {
      const int id = tid + 256 * i, e = id >> 3, ch = id & 7;
      *(u32x4*)(st + e * 128 + ((ch ^ (e & 7)) * 16)) = dir ? sg1[i] : sg0[i];
    }
    __syncthreads();
    bf16x8 qf[2];
#pragma unroll
    for (int ks = 0; ks < 2; ++ks) qf[ks] = *(const bf16x8*)(qd + (wave * 16 + fr) * 128 + (((ks * 4 + fq) ^ (fr & 7)) * 16));
    f32x4 at[4];
#pragma unroll
    for (int sb = 0; sb < 4; ++sb) {
      at[sb] = (f32x4){0.f, 0.f, 0.f, 0.f};
#pragma unroll
      for (int ks = 0; ks < 2; ++ks) {
        const bf16x8 kf = *(const bf16x8*)(ki + (sb * 16 + fr) * 128 + (((ks * 4 + fq) ^ (fr & 7)) * 16));
        at[sb] = mfma16(kf, qf[ks], at[sb]);
      }
      const int tt = wave * 16 + fr;
#pragma unroll
      for (int j = 0; j < 4; ++j) {
        const int s_ = sb * 16 + fq * 4 + j;
        const bool keep = dir ? (s_ >= tt) : (s_ <= tt);
        if (!keep) at[sb][j] = 0.f;
      }
    }
#pragma unroll
    for (int ks2 = 0; ks2 < 2; ++ks2) {
      const uint2 lo = pack4(at[2 * ks2]), hi = pack4(at[2 * ks2 + 1]);
      union { uint4 u; bf16x8 v; } pf; pf.u = make_uint4(lo.x, lo.y, hi.x, hi.y);
#pragma unroll
      for (int eb = 0; eb < 8; ++eb) {
        const int rw = eb * 16 + fr, sw = ((rw >> 1) & 7) << 1;
        union { uint2 u[2]; bf16x8 v; } vf;
        vf.u[0] = *(const uint2*)(vt + rw * 128 + (((ks2 * 8 + fq) ^ sw) * 8));
        vf.u[1] = *(const uint2*)(vt + rw * 128 + (((ks2 * 8 + 4 + fq) ^ sw) * 8));
        o[eb] = mfma16(vf.v, pf.v, o[eb]);
      }
    }
#pragma unroll
    for (int ks = 0; ks < 2; ++ks)
#pragma unroll
      for (int eb = 0; eb < 8; ++eb) {
        const bf16x8 sf = *(const bf16x8*)(st + (eb * 16 + fr) * 128 + (((ks * 4 + fq) ^ (fr & 7)) * 16));
        o[eb] = mfma16(sf, qf[ks], o[eb]);
      }
  }
  float ss = 0.f;
#pragma unroll
  for (int eb = 0; eb < 8; ++eb)
#pragma unroll
    for (int j = 0; j < 4; ++j) ss += o[eb][j] * o[eb][j];
  ss += __shfl_xor(ss, 16); ss += __shfl_xor(ss, 32);
  const float rstd = rsqrtf(ss * (1.f / 128.f) + EPS);
  const float* nw = p.gla_nw + layer * 128;
#pragma unroll
  for (int eb = 0; eb < 8; ++eb) {
    const int e0 = eb * 16 + fq * 4;
    const f32x4 gg = {bflo(gw[eb][0]), bfhi(gw[eb][0]), bflo(gw[eb][1]), bfhi(gw[eb][1])};
    f32x4 y;
#pragma unroll
    for (int j = 0; j < 4; ++j) y[j] = o[eb][j] * rstd * nw[e0 + j] * gg[j] * __builtin_amdgcn_rcpf(1.f + __expf(-gg[j]));
    *(uint2*)(p.yb + (size_t)row * 512 + h * 128 + e0) = pack4(y);
  }
}

DEVI void phase_p2(const P& p, int layer, unsigned char* smem) {
  constexpr int MT = MH / 128;
  float* rs = (float*)(smem + 3 * (128 + 128) * 64);
  const int nQ = MT * 6, nKV = MT * 8, nKR = 144, nG1 = HB * 4 * 2 * 36;
  for (int it = vbid(); it < nQ + nKV + nKR + nG1; it += vnb()) {
    if (it < nQ) {
      const int mt = it % MT, nt = it / MT, m0 = mt * 128, n0 = nt * 128;
      f32x4 acc[4][4];
      __syncthreads();
      row_rstd128(p.z + (size_t)m0 * ZW + ZQD, ZW, 384, rs);
      gemm_dma<4>(p.z + (size_t)m0 * ZW + ZQD, ZW, p.Wq + (size_t)n0 * 384, 384, 384, acc, smem);
      const int tid = otid(), lane = tid & 63, wave = tid >> 6, wm = wave >> 1, wn = wave & 1, fr = lane & 15, fq = lane >> 4;
#pragma unroll
      for (int mi = 0; mi < 4; ++mi) {
        const int m = wm * 64 + mi * 16 + fr, r = m0 + m;
        const float rstd = rs[m] * (0.10206207261596577f * LOG2E);
        const bool lat = r < ML;
        const int t = r & 2047;
#pragma unroll
        for (int np = 0; np < 2; ++np) {
          const int nb = n0 + wn * 64 + np * 32;
          f32x4 v0 = acc[mi][2 * np] * rstd, v1 = acc[mi][2 * np + 1] * rstd;
          if (lat && (nb % 96) == 64) {
            const float4 c4 = *(const float4*)(p.ropec + t * 16 + fq * 4), s4 = *(const float4*)(p.ropes + t * 16 + fq * 4);
            f32x4 cc = {c4.x, c4.y, c4.z, c4.w}, sn = {s4.x, s4.y, s4.z, s4.w};
            const f32x4 x1 = v0, x2 = v1;
            v0 = x1 * cc - x2 * sn;
            v1 = x1 * sn + x2 * cc;
          }
          *(uint2*)(p.Qm + (size_t)r * 768 + nb + fq * 4) = pack4(v0);
          *(uint2*)(p.Qm + (size_t)r * 768 + nb + 16 + fq * 4) = pack4(v1);
        }
      }
    } else if (it < nQ + nKV) {
      const int i2 = it - nQ, mt = i2 % MT, hd = i2 / MT, m0 = mt * 128, n0 = hd * 128;
      f32x4 acc[4][4];
      __syncthreads();
      row_rstd128(p.z + (size_t)m0 * ZW + ZKVD, ZW, 256, rs);
      gemm_dma<4>(p.z + (size_t)m0 * ZW + ZKVD, ZW, p.Wkv + (size_t)n0 * 256, 256, 256, acc, smem);
      FOR_ACC(4, acc, {
        int bl, pos;
        row_bp(m0 + m, bl, pos);
        v = v * rs[m];
        if (n < 64) {
          *(uint2*)(p.Km + ((size_t)(bl * 8 + hd) * KVP + pos) * 96 + n) = pack4(v);
        } else {
          bf16_t* dst = p.Vtm + ((size_t)(bl * 8 + hd) * 64 + (n - 64)) * KVP + pos;
          _Pragma("unroll") for (int j = 0; j < 4; ++j) dst[(size_t)j * KVP] = f2bf(v[j]);
        }
      })
    } else if (it < nQ + nKV + nKR) {
      const int i3 = it - nQ - nKV;
      const int tid = otid();
      const int r = i3 * 128 + (tid >> 1), half = tid & 1;
      int bl, pos;
      row_bp(r, bl, pos);
      const bf16_t* zr = p.z + (size_t)r * ZW + ZKR;
      const uint4 a = *(const uint4*)(zr + half * 8), b = *(const uint4*)(zr + 16 + half * 8);
      float x1[8] = {bflo(a.x), bfhi(a.x), bflo(a.y), bfhi(a.y), bflo(a.z), bfhi(a.z), bflo(a.w), bfhi(a.w)};
      float x2[8] = {bflo(b.x), bfhi(b.x), bflo(b.y), bfhi(b.y), bflo(b.z), bfhi(b.z), bflo(b.w), bfhi(b.w)};
      if (r < ML) {
#pragma unroll
        for (int j = 0; j < 8; ++j) {
          const float cs = p.ropec[pos * 16 + half * 8 + j], sn = p.ropes[pos * 16 + half * 8 + j];
          const float y1 = x1[j] * cs - x2[j] * sn, y2 = x1[j] * sn + x2[j] * cs;
          x1[j] = y1; x2[j] = y2;
        }
      }
      const uint4 o1 = make_uint4(cvt_pk(x1[0], x1[1]), cvt_pk(x1[2], x1[3]), cvt_pk(x1[4], x1[5]), cvt_pk(x1[6], x1[7]));
      const uint4 o2 = make_uint4(cvt_pk(x2[0], x2[1]), cvt_pk(x2[2], x2[3]), cvt_pk(x2[4], x2[5]), cvt_pk(x2[6], x2[7]));
#pragma unroll
      for (int hd = 0; hd < 8; ++hd) {
        bf16_t* kp = p.Km + ((size_t)(bl * 8 + hd) * KVP + pos) * 96 + 64;
        *(uint4*)(kp + half * 8) = o1;
        *(uint4*)(kp + 16 + half * 8) = o2;
      }
    } else {
      gla_g1_item(p, layer, it - nQ - nKV - nKR, smem);
    }
  }
}

struct Seg { const bf16_t* k; int ks; const bf16_t* vt; int vs; int nt; };

template <int DQK, int QB, bool NA>
DEVI void attn_item(const bf16_t* __restrict__ q, int qs, Seg s0, Seg s1, bf16_t* __restrict__ o, int os, float scale_l2,
                    const float* __restrict__ rpb_g, int na_roff, unsigned char* smem) {
  constexpr int CH = DQK / 8, RSK = (DQK == 96) ? 256 : 128, MASK = (DQK == 96) ? 15 : 7, NKS = DQK / 32;
  constexpr int KCH = 64 * CH / 256;
  const int tid = otid(), lane = tid & 63, wave = tid >> 6, fr = lane & 15, fq = lane >> 4;
  float* bias = (float*)(smem + 49152);
  __syncthreads();
  if (NA) {
    for (int e = tid; e < 15 * 31; e += 256) bias[e] = rpb_g[e] * LOG2E;
  }
  bf16x8 qf[QB][NKS];
#pragma unroll
  for (int qb = 0; qb < QB; ++qb)
#pragma unroll
    for (int ks = 0; ks < NKS; ++ks) qf[qb][ks] = *(const bf16x8*)(q + (size_t)(wave * QB * 16 + qb * 16 + fr) * qs + ks * 32 + fq * 8);
  f32x4 O[4][QB];
  float mrow[QB], lrow[QB];
#pragma unroll
  for (int qb = 0; qb < QB; ++qb) {
    mrow[qb] = -1e30f; lrow[qb] = 0.f;
#pragma unroll
    for (int db = 0; db < 4; ++db) O[db][qb] = (f32x4){0.f, 0.f, 0.f, 0.f};
  }
  const int T = s0.nt + s1.nt;
  uint4 rk0, rk1, rk2 = make_uint4(0, 0, 0, 0), rv0, rv1;
  for (int t = -1; t < T; ++t) {
    const int cur = t & 1;
    if (t + 1 < T) {
      const int t1 = t + 1;
      const bool first = t1 < s0.nt;
      const bf16_t* kp = first ? s0.k : s1.k;
      const bf16_t* vp = first ? s0.vt : s1.vt;
      const int ks_ = first ? s0.ks : s1.ks, vs_ = first ? s0.vs : s1.vs, tt = first ? t1 : t1 - s0.nt;
#define LDK_(i, dst) { const int id = tid + 256 * (i), row = id / CH, ch = id % CH; dst = *(const uint4*)(kp + (size_t)(tt * 64 + row) * ks_ + ch * 8); }
#define LDV_(i, dst) { const int id = tid + 256 * (i), row = id >> 3, ch = id & 7; dst = *(const uint4*)(vp + (size_t)row * vs_ + tt * 64 + ch * 8); }
      LDK_(0, rk0) LDK_(1, rk1) if (KCH > 2) LDK_(2, rk2)
      LDV_(0, rv0) LDV_(1, rv1)
    }
    if (t >= 0) {
    const unsigned char* kb = smem + cur * 24576;
    const unsigned char* vb = kb + 16384;
    f32x4 S[4][QB];
#pragma unroll
    for (int kbk = 0; kbk < 4; ++kbk) {
#pragma unroll
      for (int qb = 0; qb < QB; ++qb) S[kbk][qb] = (f32x4){0.f, 0.f, 0.f, 0.f};
#pragma unroll
      for (int ks = 0; ks < NKS; ++ks) {
        const bf16x8 kf = *(const bf16x8*)(kb + (kbk * 16 + fr) * RSK + (((ks * 4 + fq) ^ (fr & MASK)) * 16));
#pragma unroll
        for (int qb = 0; qb < QB; ++qb) S[kbk][qb] = mfma16(kf, qf[qb][ks], S[kbk][qb]);
      }
    }
    const bool band = NA && (t < s0.nt);
#pragma unroll
    for (int qb = 0; qb < QB; ++qb) {
      float mx = mrow[qb];
#pragma unroll
      for (int kbk = 0; kbk < 4; ++kbk)
#pragma unroll
        for (int j = 0; j < 4; ++j) {
          float s = S[kbk][qb][j];
          if (NA) {
            if (band) {
              const int qc = wave * 16 + fr, kc = kbk * 16 + fq * 4 + j;
              const int cs = min(max(qc - 8, 0), 48);
              const int co = min(max(kc - qc + 15, 0), 30);
              s += bias[(na_roff + t) * 31 + co];
              if (kc < cs || kc >= cs + 16) s = -1e30f;
            }
          }
          S[kbk][qb][j] = s;
          mx = fmaxf(mx, s);
        }
      mx = xrow16_max(mx);
      const float alpha = __builtin_amdgcn_exp2f(mrow[qb] - mx);
      mrow[qb] = mx;
      float ls = 0.f;
#pragma unroll
      for (int kbk = 0; kbk < 4; ++kbk)
#pragma unroll
        for (int j = 0; j < 4; ++j) {
          const float pv = __builtin_amdgcn_exp2f(S[kbk][qb][j] - mx);
          S[kbk][qb][j] = pv;
          ls += pv;
        }
      lrow[qb] = lrow[qb] * alpha + ls;
      if (__any(alpha != 1.f)) {
#pragma unroll
        for (int db = 0; db < 4; ++db) O[db][qb] = O[db][qb] * alpha;
      }
    }
#pragma unroll
    for (int ks2 = 0; ks2 < 2; ++ks2) {
      bf16x8 pf[QB];
#pragma unroll
      for (int qb = 0; qb < QB; ++qb) {
        const uint2 lo = pack4(S[2 * ks2][qb]), hi = pack4(S[2 * ks2 + 1][qb]);
        union { uint4 u; bf16x8 v; } cv; cv.u = make_uint4(lo.x, lo.y, hi.x, hi.y);
        pf[qb] = cv.v;
      }
#pragma unroll
      for (int db = 0; db < 4; ++db) {
        const int row = db * 16 + fr, sw = ((row >> 1) & 7) << 1;
        union { uint2 u[2]; bf16x8 v; } vf;
        vf.u[0] = *(const uint2*)(vb + row * 128 + (((ks2 * 8 + fq) ^ sw) * 8));
        vf.u[1] = *(const uint2*)(vb + row * 128 + (((ks2 * 8 + 4 + fq) ^ sw) * 8));
#pragma unroll
        for (int qb = 0; qb < QB; ++qb) O[db][qb] = mfma16(vf.v, pf[qb], O[db][qb]);
      }
    }
    }
    if (t + 1 < T) {
      unsigned char* kb2 = smem + (cur ^ 1) * 24576;
      unsigned char* vb2 = kb2 + 16384;
#define STK_(i, src) { const int id = tid + 256 * (i), row = id / CH, ch = id % CH; *(uint4*)(kb2 + row * RSK + ((ch ^ (row & MASK)) * 16)) = src; }
#define STV_(i, src) { const int id = tid + 256 * (i), row = id >> 3, ch = id & 7; *(uint4*)(vb2 + row * 128 + ((ch ^ ((row >> 1) & 7)) * 16)) = src; }
      STK_(0, rk0) STK_(1, rk1) if (KCH > 2) STK_(2, rk2)
      STV_(0, rv0) STV_(1, rv1)
    }
    __syncthreads();
  }
#pragma unroll
  for (int qb = 0; qb < QB; ++qb) {
    float l = lrow[qb];
    l += __shfl_xor(l, 16); l += __shfl_xor(l, 32);
    const float inv = 1.f / l;
    bf16_t* op = o + (size_t)(wave * QB * 16 + qb * 16 + fr) * os + fq * 4;
#pragma unroll
    for (int db = 0; db < 4; ++db) *(uint2*)(op + db * 16) = pack4(O[db][qb] * inv);
  }
}

constexpr int P3_NS = HB * 4 * 2 * 16, P3_NA = HB * 8 * 16, P3_NG = HB * 4 * 36, P3_NN = HB * 8 * 32, P3_NC = HB * 8 * 2;
constexpr int P3_SPLIT = P3_NS + P3_NA / 2;
DEVI void gla_g3_item(const P& p, int layer, int item, unsigned char* smem);
DEVI void phase_p3(const P& p, int layer, bool need_ctx, unsigned char* smem, int begin, int end) {
  const int nA = P3_NA, nN = P3_NN, nAc = need_ctx ? P3_NC : 0, nNc = nAc;
  const float mla_sc = 0.10206207261596577f * LOG2E;
  const float na_sc = 0.125f * LOG2E;
  const Seg none = {nullptr, 0, nullptr, 0, 0};
  const int tot = P3_NS + P3_NA + P3_NG + nN + nAc + nNc;
  if (end > tot) end = tot;
  for (int itg = begin + vbid(); itg < end; itg += vnb()) {
    if (itg < P3_NS) { gla_scan_item(p, itg); continue; }
    if (itg >= P3_NS + P3_NA && itg < P3_NS + P3_NA + P3_NG) {
      const int gi = itg - P3_NS - P3_NA;
      if (need_ctx || (gi % 36) >= 4) gla_g3_item(p, layer, gi, smem);
      continue;
    }
    const int it = itg < P3_NS + P3_NA ? itg - P3_NS : itg - P3_NS - P3_NG;
    if (it < nA) {
      const int qb = it & 15, hd = (it >> 4) & 7, bl = it >> 7;
      const int r0 = bl * 2048 + qb * 128;
      Seg s = {p.Km + (size_t)(bl * 8 + hd) * KVP * 96, 96, p.Vtm + (size_t)(bl * 8 + hd) * 64 * KVP, KVP, 36};
      attn_item<96, 2, false>(p.Qm + (size_t)r0 * 768 + hd * 96, 768, s, none, p.ya + (size_t)r0 * 512 + hd * 64, 512, mla_sc, nullptr, 0, smem);
    } else if (it < nA + nN) {
      const int i2 = it - nA, r = i2 & 31, hd = (i2 >> 5) & 7, bl = i2 >> 8;
      const int rr0 = min(max(r - 4, 0), 24);
      const int row0 = bl * 2048 + r * 64;
      Seg sb = {p.z + (size_t)(bl * 2048 + rr0 * 64) * ZW + ZNK + hd * 64, ZW, p.Vtn + (size_t)(bl * 8 + hd) * 64 * KVP + rr0 * 64, KVP, 8};
      Seg sc = {p.z + (size_t)(ML + bl * 256) * ZW + ZNK + hd * 64, ZW, p.Vtn + (size_t)(bl * 8 + hd) * 64 * KVP + SEQ, KVP, 4};
      attn_item<64, 1, true>(p.z + (size_t)row0 * ZW + ZNQ + hd * 64, ZW, sb, sc, p.yc + (size_t)row0 * 512 + hd * 64, 512, na_sc,
                             p.rpb + ((size_t)layer * 8 + hd) * 15 * 31, rr0 - r + 7, smem);
    } else if (it < nA + nN + nAc) {
      const int i3 = it - nA - nN, qb = i3 & 1, hd = (i3 >> 1) & 7, bl = i3 >> 4;
      const int r0 = ML + bl * 256 + qb * 128;
      Seg s = {p.Km + ((size_t)(bl * 8 + hd) * KVP + SEQ) * 96, 96, p.Vtm + (size_t)(bl * 8 + hd) * 64 * KVP + SEQ, KVP, 4};
      attn_item<96, 2, false>(p.Qm + (size_t)r0 * 768 + hd * 96, 768, s, none, p.ya + (size_t)r0 * 512 + hd * 64, 512, mla_sc, nullptr, 0, smem);
    } else {
      const int i4 = it - nA - nN - nAc, qb = i4 & 1, hd = (i4 >> 1) & 7, bl = i4 >> 4;
      const int r0 = ML + bl * 256 + qb * 128;
      Seg s = {p.z + (size_t)(ML + bl * 256) * ZW + ZNK + hd * 64, ZW, p.Vtn + (size_t)(bl * 8 + hd) * 64 * KVP + SEQ, KVP, 4};
      attn_item<64, 2, false>(p.z + (size_t)r0 * ZW + ZNQ + hd * 64, ZW, s, none, p.yc + (size_t)r0 * 512 + hd * 64, 512, na_sc, nullptr, 0, smem);
    }
  }
}

template <int MI>
DEVI void phase_p5(const P& p, int Mrows, unsigned char* smem) {
  constexpr int BM = MI * 32;
  const int MT = Mrows / BM;
  for (int it = vbid(); it < MT * 8; it += vnb()) {
    const int mt = it % MT, nt = it / MT, m0 = mt * BM, n0 = nt * 128;
    f32x4 macc[MI][4];
#pragma unroll
    for (int a = 0; a < MI; ++a)
#pragma unroll
      for (int b = 0; b < 4; ++b) macc[a][b] = (f32x4){0.f, 0.f, 0.f, 0.f};
    for (int br = 0; br < 3; ++br) {
      uint2 gs[MI][4];
      {
        f32x4 g[MI][4];
        gemm_dma<MI>(p.u + (size_t)m0 * D, D, p.WinG + (size_t)(br * 1024 + n0) * D, D, D, g, smem);
#pragma unroll
        for (int a = 0; a < MI; ++a)
#pragma unroll
          for (int b = 0; b < 4; ++b) {
            f32x4 sg;
#pragma unroll
            for (int j = 0; j < 4; ++j) sg[j] = sigmoidf_(g[a][b][j]);
            gs[a][b] = pack4(sg);
          }
      }
      f32x4 y[MI][4];
      const bf16_t* yb = br == 0 ? p.ya : (br == 1 ? p.yb : p.yc);
      const bf16_t* wb = br == 0 ? p.Wa : (br == 1 ? p.Wb : p.Wc);
      gemm_dma<MI>(yb + (size_t)m0 * 512, 512, wb + (size_t)n0 * 512, 512, 512, y, smem);
#pragma unroll
      for (int a = 0; a < MI; ++a)
#pragma unroll
        for (int b = 0; b < 4; ++b) {
          macc[a][b][0] += bflo(gs[a][b].x) * y[a][b][0];
          macc[a][b][1] += bfhi(gs[a][b].x) * y[a][b][1];
          macc[a][b][2] += bflo(gs[a][b].y) * y[a][b][2];
          macc[a][b][3] += bfhi(gs[a][b].y) * y[a][b][3];
        }
    }
    FOR_ACC(MI, macc, { *(uint2*)(p.mbuf + (size_t)(m0 + m) * D + n0 + n) = pack4(v); })
  }
}


DEVI uint2 ld_own(const void* ptr) {
  const unsigned long long w = __hip_atomic_load((const unsigned long long*)ptr, __ATOMIC_RELAXED, __HIP_MEMORY_SCOPE_AGENT);
  uint2 r; r.x = (unsigned)w; r.y = (unsigned)(w >> 32); return r;
}
template <int MI>
DEVI void phase_p5x(const P& p, int Mrows, unsigned char* smem) {
  constexpr int BM = MI * 32;
  const int MT = Mrows / BM;
  uint2* yscr = (uint2*)p.z + (size_t)blockIdx.x * (MI * 4 * 512);
  for (int pr = blockIdx.x; pr < MT * 4; pr += gridDim.x) {
    const int mt = pr % MT, nq = pr / MT, m0 = mt * BM, n0 = nq * 256;
    for (int br = 0; br < 3; ++br) {
      const bf16_t* ybr = br == 0 ? p.ya : (br == 1 ? p.yb : p.yc);
      const bf16_t* wbr = br == 0 ? p.Wa : (br == 1 ? p.Wb : p.Wc);
      {
        f32x4 y[MI][4];
        gemm_dma8<MI>(ybr + (size_t)m0 * 512, 512, wbr + (size_t)n0 * 512, 512, 512, y, smem);
        const int t8 = otid8();
#pragma unroll
        for (int mi = 0; mi < MI; ++mi)
#pragma unroll
          for (int ni = 0; ni < 4; ++ni) yscr[(mi * 4 + ni) * 512 + t8] = pack4(y[mi][ni]);
      }
      f32x4 g[MI][4];
      gemm_dma8<MI>(p.u + (size_t)m0 * D, D, p.WinG + (size_t)(br * 1024 + n0) * D, D, D, g, smem);
      {
        const int t8 = otid8(), l8 = t8 & 63, w8 = t8 >> 6, wm8 = w8 >> 2, wn8 = w8 & 3, fr8 = l8 & 15, fq8 = l8 >> 4;
        u32x2 yw[2][4], mw[2][4];
        bf16_t* mpp[2];
#define P5_LOAD(mi_, s_)                                                                                    \
        {                                                                                                   \
          mpp[s_] = p.mbuf + (size_t)(m0 + wm8 * MI * 16 + (mi_) * 16 + fr8) * D + n0 + wn8 * 64 + fq8 * 4; \
          _Pragma("unroll") for (int ni = 0; ni < 4; ++ni) {                                                \
            const uint2 a_ = ld_own(yscr + ((mi_) * 4 + ni) * 512 + t8);                                    \
            yw[s_][ni] = (u32x2){a_.x, a_.y};                                                               \
            if (br > 0) { const uint2 b_ = ld_own(mpp[s_] + ni * 16); mw[s_][ni] = (u32x2){b_.x, b_.y}; }   \
            else mw[s_][ni] = (u32x2){0u, 0u};                                                              \
          }                                                                                                 \
        }
        P5_LOAD(0, 0)
#pragma unroll
        for (int mi = 0; mi < MI; ++mi) {
          if (mi + 1 < MI) { if (mi & 1) P5_LOAD(mi + 1, 0) else P5_LOAD(mi + 1, 1) }
#pragma unroll
          for (int ni = 0; ni < 4; ++ni) {
            const f32x4 v = g[mi][ni];
            const u32x2 y2 = yw[mi & 1][ni], m2 = mw[mi & 1][ni];
            f32x4 outv;
            outv[0] = sigmoidf_(v[0]) * bflo(y2[0]) + bflo(m2[0]); outv[1] = sigmoidf_(v[1]) * bfhi(y2[0]) + bfhi(m2[0]);
            outv[2] = sigmoidf_(v[2]) * bflo(y2[1]) + bflo(m2[1]); outv[3] = sigmoidf_(v[3]) * bfhi(y2[1]) + bfhi(m2[1]);
            *(uint2*)(mpp[mi & 1] + ni * 16) = pack4(outv);
          }
        }
      }
    }
  }
}

template <int MI>
DEVI void phase_res(const P& p, int g, int layer, const bf16_t* A, int K, const bf16_t* W, int gate_off, const float* hl, const float* hcx, int Mrows,
                    unsigned char* smem) {
  constexpr int BM = MI * 32;
  const int MT = Mrows / BM;
  for (int it = blockIdx.x; it < MT * 4; it += gridDim.x) {
    const int mt = it % MT, nt = it / MT, m0 = mt * BM, n0 = nt * 256;
    f32x4 acc[MI][4];
    gemm_dma8<MI>(A + (size_t)m0 * K, K, W + (size_t)n0 * K, K, K, acc, smem);
    {
      const int t8 = otid8(), l8 = t8 & 63, w8 = t8 >> 6, wm8 = w8 >> 2, wn8 = w8 & 3, fr8 = l8 & 15, fq8 = l8 >> 4;
      const int cb = n0 + wn8 * 64 + fq8 * 4;
      f32x4 hv[2][4], gv[2][4];
      bf16_t* dstp[2];
#define RES_LOAD(mi_, s_)                                                                                   \
      {                                                                                                     \
        const int r_ = m0 + wm8 * MI * 16 + (mi_) * 16 + fr8;                                               \
        const bool lat_ = r_ < ML;                                                                          \
        const size_t ro_ = lat_ ? ((size_t)g * ML + r_) * D : ((size_t)g * MC + (r_ - ML)) * D;            \
        dstp[s_] = (lat_ ? p.hbl : p.hbc) + ro_ + cb;                                                       \
        const int b_ = lat_ ? g * HB + (r_ >> 11) : 16;                                                     \
        const float* gp_ = p.mod + ((size_t)layer * 17 + b_) * 6144 + gate_off + cb;                        \
        if (hl) {                                                                                           \
          const float* src_ = (lat_ ? hl : hcx) + ro_ + cb;                                                 \
          _Pragma("unroll") for (int ni = 0; ni < 4; ++ni) { hv[s_][ni] = *(const f32x4*)(src_ + ni * 16); gv[s_][ni] = *(const f32x4*)(gp_ + ni * 16); } \
        } else {                                                                                            \
          const bf16_t* src_ = dstp[s_];                                                                    \
          _Pragma("unroll") for (int ni = 0; ni < 4; ++ni) {                                                \
            const u32x2 w_ = *(const u32x2*)(src_ + ni * 16);                                               \
            hv[s_][ni] = (f32x4){bflo(w_[0]), bfhi(w_[0]), bflo(w_[1]), bfhi(w_[1])};                       \
            gv[s_][ni] = *(const f32x4*)(gp_ + ni * 16);                                                    \
          }                                                                                                 \
        }                                                                                                   \
      }
      RES_LOAD(0, 0)
#pragma unroll
      for (int mi = 0; mi < MI; ++mi) {
        if (mi + 1 < MI) { if (mi & 1) RES_LOAD(mi + 1, 0) else RES_LOAD(mi + 1, 1) }
#pragma unroll
        for (int ni = 0; ni < 4; ++ni) *(uint2*)(dstp[mi & 1] + ni * 16) = pack4(hv[mi & 1][ni] + gv[mi & 1][ni] * acc[mi][ni]);
      }
    }
  }
}

template <int MI>
DEVI void phase_p7(const P& p, int Mrows, unsigned char* smem) {
  constexpr int BM = MI * 32;
  const int MT = Mrows / BM;
  for (int it = blockIdx.x; it < MT * 22; it += gridDim.x) {
    const int mt = it % MT, nt = it / MT, m0 = mt * BM, n0 = nt * 256;
    f32x4 acc[MI][4];
    gemm_dma8<MI>(p.u + (size_t)m0 * D, D, p.Wfi + (size_t)n0 * D, D, D, acc, smem);
    const int tid = otid8(), lane = tid & 63, wave = tid >> 6, wm = wave >> 2, wn = wave & 3, fr = lane & 15, fq = lane >> 4;
#pragma unroll
    for (int mi = 0; mi < MI; ++mi) {
      const int r = m0 + wm * MI * 16 + mi * 16 + fr;
#pragma unroll
      for (int ni = 0; ni < 2; ++ni) {
        f32x4 a;
#pragma unroll
        for (int j = 0; j < 4; ++j) { const float gv = acc[mi][ni][j]; a[j] = gv * __builtin_amdgcn_rcpf(1.f + __expf(-gv)) * acc[mi][ni + 2][j]; }
        *(uint2*)(p.act + (size_t)r * FFH + nt * 128 + wn * 32 + ni * 16 + fq * 4) = pack4(a);
      }
    }
  }
}

DEVI void phase_final(const P& p) {
  const int tid = otid(), lane = tid & 63, wave = tid >> 6;
  const int stride = vnb() * 4, NR = NBATCH * SEQ;
  for (int r0 = vbid() * 4 + wave; r0 < NR; r0 += 2 * stride) {
    const int r1 = r0 + stride;
    const bool has1 = r1 < NR;
    const int rr1 = has1 ? r1 : r0;
    const bf16_t* h0 = p.hbl + (size_t)r0 * D;
    const bf16_t* h1 = p.hbl + (size_t)rr1 * D;
    u32x2 w0[4], w1[4];
#pragma unroll
    for (int i = 0; i < 4; ++i) { w0[i] = *(const u32x2*)(h0 + i * 256 + lane * 4); w1[i] = *(const u32x2*)(h1 + i * 256 + lane * 4); }
    f32x4 v0[4], v1[4];
    float s0 = 0.f, s1 = 0.f;
#pragma unroll
    for (int i = 0; i < 4; ++i) {
      v0[i] = (f32x4){bflo(w0[i][0]), bfhi(w0[i][0]), bflo(w0[i][1]), bfhi(w0[i][1])};
      v1[i] = (f32x4){bflo(w1[i][0]), bfhi(w1[i][0]), bflo(w1[i][1]), bfhi(w1[i][1])};
      s0 += v0[i][0] * v0[i][0] + v0[i][1] * v0[i][1] + v0[i][2] * v0[i][2] + v0[i][3] * v0[i][3];
      s1 += v1[i][0] * v1[i][0] + v1[i][1] * v1[i][1] + v1[i][2] * v1[i][2] + v1[i][3] * v1[i][3];
    }
#pragma unroll
    for (int o = 1; o < 64; o <<= 1) { s0 += __shfl_xor(s0, o); s1 += __shfl_xor(s1, o); }
    const float rstd0 = rsqrtf(s0 * (1.f / D) + EPS), rstd1 = rsqrtf(s1 * (1.f / D) + EPS);
    float* q0 = p.out + (size_t)r0 * D;
    float* q1 = p.out + (size_t)rr1 * D;
#pragma unroll
    for (int i = 0; i < 4; ++i) {
      const float4 w4 = *(const float4*)(p.final_w + i * 256 + lane * 4);
      const f32x4 wv = {w4.x, w4.y, w4.z, w4.w};
      *(f32x4*)(q0 + i * 256 + lane * 4) = v0[i] * rstd0 * wv;
      if (has1) *(f32x4*)(q1 + i * 256 + lane * 4) = v1[i] * rstd1 * wv;
    }
  }
}

constexpr int SUBLDS = 60416;
constexpr int DYN_LDS = 4 * (288 + 256) * 64;
static_assert(2 * SUBLDS <= DYN_LDS, "LDS regions");
__global__ void __launch_bounds__(512, 2) fwd_megakernel(P p) {
  extern __shared__ __attribute__((aligned(16))) unsigned char smem[];
  __shared__ uint4 xb_words;
  cg::grid_group grid = cg::this_grid();
  if (threadIdx.x == 0) xb_words = make_uint4(0u, 0u, 0u, 0u);
  __syncthreads();
  XcdBarrier xb = xcd_barrier_post(p.bar, (volatile LAS unsigned*)&xb_words);
  unsigned char* smh = smem + osub() * SUBLDS;
  phase_prep(p, smh);
  for (int layer = 0; layer < DEPTH; ++layer) {
    if (layer > 0) xcd_barrier(xb);
    phase_conv(p, layer, smh);
    const bool need_ctx = layer < DEPTH - 1;
    const int Mres = need_ctx ? MH : ML;
    for (int g = 0; g < 2; ++g) {
      const float* hl = layer == 0 ? p.x : nullptr;
      const float* hcx = layer == 0 ? p.ctx : nullptr;
      if (layer == 0 && g == 0) {
        grid.sync();
        phase_norm(p, 0, 0, 0, p.x, p.ctx, MH);
      }
      xcd_barrier(xb);
      phase_p1(p, smem);
      xcd_barrier(xb);
      phase_p2(p, layer, smh);
      xcd_barrier(xb);
      phase_p3(p, layer, need_ctx, smh, 0, P3_SPLIT);
      xcd_barrier(xb);
      phase_p3(p, layer, need_ctx, smh, P3_SPLIT, 1 << 30);
      xcd_barrier(xb);
      if (need_ctx) phase_p5x<9>(p, MH, smem); else phase_p5x<8>(p, ML, smem);
      xcd_barrier(xb);
      if (need_ctx) phase_res<9>(p, g, layer, p.mbuf, D, p.Wout, 2048, hl, hcx, MH, smem); else phase_res<8>(p, g, layer, p.mbuf, D, p.Wout, 2048, hl, hcx, ML, smem);
      xcd_barrier(xb);
      phase_norm(p, g, layer, 1, nullptr, nullptr, Mres);
      xcd_barrier(xb);
      if (need_ctx) phase_p7<9>(p, MH, smem); else phase_p7<8>(p, ML, smem);
      xcd_barrier(xb);
      if (need_ctx) phase_res<9>(p, g, layer, p.act, FFH, p.Wfo, 5120, nullptr, nullptr, MH, smem); else phase_res<8>(p, g, layer, p.act, FFH, p.Wfo, 5120, nullptr, nullptr, ML, smem);
      if (g == 0) phase_norm(p, 1, layer, 0, hl, hcx, MH);
      else if (layer + 1 < DEPTH) phase_norm(p, 0, layer + 1, 0, nullptr, nullptr, MH);
    }
  }
  xcd_barrier(xb);
  phase_final(p);
}

extern "C" void kernel_launch(void* const* d_in, const int* in_sizes, int n_in, void* d_out, int out_size, void* d_ws, size_t ws_size,
                              hipStream_t stream) {
  static int grid_blocks = 0;
  if (!grid_blocks) {
    int dev = 0, cus = 0, per_cu = 0;
    (void)hipGetDevice(&dev);
    (void)hipDeviceGetAttribute(&cus, hipDeviceAttributeMultiprocessorCount, dev);
    (void)hipFuncSetAttribute((const void*)fwd_megakernel, hipFuncAttributeMaxDynamicSharedMemorySize, DYN_LDS);
    (void)hipOccupancyMaxActiveBlocksPerMultiprocessor(&per_cu, fwd_megakernel, 512, DYN_LDS);
    if (per_cu > 1) per_cu = 1;
    if (per_cu < 1) per_cu = 1;
    grid_blocks = cus * per_cu;
  }
  P p{};
  const float** ip = (const float**)&p;
  for (int i = 0; i < 26; ++i) ip[i] = (const float*)d_in[i];
  p.out = (float*)d_out;
  unsigned char* w = (unsigned char*)d_ws;
  size_t off = 0;
  auto take = [&](size_t bytes) { unsigned char* r = w + off; off += (bytes + 255) & ~(size_t)255; return r; };
  p.WinA = (bf16_t*)take((size_t)ZN * D * 2);
  p.WinG = (bf16_t*)take((size_t)3072 * D * 2);
  p.Wq = (bf16_t*)take((size_t)768 * 384 * 2);
  p.Wkv = (bf16_t*)take((size_t)1024 * 256 * 2);
  p.Wa = (bf16_t*)take((size_t)D * 512 * 2);
  p.Wb = (bf16_t*)take((size_t)D * 512 * 2);
  p.Wc = (bf16_t*)take((size_t)D * 512 * 2);
  p.Wout = (bf16_t*)take((size_t)D * D * 2);
  p.Wfi = (bf16_t*)take((size_t)2 * FFH * D * 2);
  p.Wfo = (bf16_t*)take((size_t)D * FFH * 2);
  p.mod = (float*)take((size_t)DEPTH * 17 * 6144 * 4);
  p.ropec = (float*)take((size_t)SEQ * 16 * 4);
  p.ropes = (float*)take((size_t)SEQ * 16 * 4);
  p.hc = (float*)take(256);
  p.hbl = (bf16_t*)take((size_t)NBATCH * SEQ * D * 2);
  p.hbc = (bf16_t*)take((size_t)NBATCH * CTXL * D * 2);
  p.u = (bf16_t*)take((size_t)MH * D * 2);
  {
    const size_t zb = (size_t)MH * ZW * 2, ab = (size_t)MH * FFH * 2;
    unsigned char* r1 = take(zb > ab ? zb : ab);
    p.z = (bf16_t*)r1; p.act = (bf16_t*)r1;
  }
  {
    const size_t qb = (size_t)MH * 768 * 2, kb = (size_t)HB * 8 * KVP * 96 * 2;
    unsigned char* r2 = take(qb + kb);
    p.Qm = (bf16_t*)r2; p.Km = (bf16_t*)(r2 + qb); p.mbuf = (bf16_t*)r2;
  }
  p.Vtm = (bf16_t*)take((size_t)HB * 8 * 64 * KVP * 2);
  p.Vtn = (bf16_t*)take((size_t)HB * 8 * 64 * KVP * 2);
  p.Vtg = (bf16_t*)take((size_t)HB * 4 * 128 * KVP * 2);
  p.Sg = (bf16_t*)take((size_t)HB * 4 * 2 * 36 * 8192 * 2);
  p.dec = (float*)take((size_t)HB * 4 * 2 * 36 * 64 * 4);
  p.ya = (bf16_t*)take((size_t)MH * 512 * 2);
  p.yb = (bf16_t*)take((size_t)MH * 512 * 2);
  p.yc = (bf16_t*)take((size_t)MH * 512 * 2);
  p.bar = (unsigned*)take((size_t)XCD_BAR_WORDS * 4);
  if (off > ws_size) { fprintf(stderr, "workspace too small: need %zu have %zu\n", off, ws_size); return; }
  (void)hipMemsetAsync(p.bar, 0, (size_t)XCD_BAR_WORDS * 4, stream);
  void* args[] = {&p};
  hipError_t e = hipLaunchCooperativeKernel((void*)fwd_megakernel, dim3(grid_blocks), dim3(512), args, DYN_LDS, stream);
  if (e != hipSuccess) fprintf(stderr, "cooperative launch failed: %s (grid %d)\n", hipGetErrorString(e), grid_blocks);
}
```
